# Optimizing an MI355X kernel written in HIP

```python
import math
import jax, jax.numpy as jnp
from jax import lax
import numpy as np

D_MODEL = 1024
BATCH = 8
SEQ = 4096
DEPTH = 1

CHUNK = 64
Q_BLOCK = 128
D_FF = 2816
FFN_RES_WEIGHT = 0.5
ADA_SUBLAYERS = 3
ADA_WIDTH = ADA_SUBLAYERS * 3 * D_MODEL
MLA_HEADS = 8
MLA_Q_RANK = 256
MLA_KV_RANK = 128
MLA_NOPE = 64
MLA_ROPE = 32
MLA_V = 64
ROPE_THETA = 10000.0
CA_HEADS = 8
CA_HEAD_DIM = 64
CA_LEFT_CHUNKS = 8
CA_BAND = CA_LEFT_CHUNKS + 1
MAX_REL_DIST = 256
CA_WIDTH = CA_HEADS * CA_HEAD_DIM
MLA_OUT_WIDTH = MLA_HEADS * MLA_V
W_IN_COLS = MLA_Q_RANK + MLA_KV_RANK + MLA_ROPE + 3 * CA_WIDTH + 2 * D_MODEL
EPS = 1e-6
NEG_INF = -1e30

kernel_name = "hybrid_mla_chunkattn_macaron_adaln"


def rmsnorm(x, g):
    xf = x.astype(jnp.float32)
    y = xf * lax.rsqrt(jnp.mean(xf * xf, axis=-1, keepdims=True) + EPS)
    return (y * g.astype(jnp.float32)).astype(x.dtype)


def modulate(h, shift, scale):
    return h * (1 + scale[:, None, :]) + shift[:, None, :]


def swiglu(h, w_in, w_out):
    gu = h @ w_in
    g, u = jnp.split(gu, 2, axis=-1)
    return (jax.nn.silu(g) * u) @ w_out


def rope(x, cos, sin):
    half = x.shape[-1] // 2
    x1, x2 = x[..., :half], x[..., half:]
    return jnp.concatenate([x1 * cos - x2 * sin, x1 * sin + x2 * cos], axis=-1).astype(x.dtype)


def mla_attention(q_lat, kv_lat, k_pe_raw, positions, q_norm, w_uq, kv_norm, w_ukv):
    B, S = q_lat.shape[:2]
    cq = rmsnorm(q_lat, q_norm)
    q = (cq @ w_uq).reshape(B, S, MLA_HEADS, MLA_NOPE + MLA_ROPE)
    q_nope, q_pe = q[..., :MLA_NOPE], q[..., MLA_NOPE:]
    ckv = rmsnorm(kv_lat, kv_norm)
    kv = (ckv @ w_ukv).reshape(B, S, MLA_HEADS, MLA_NOPE + MLA_V)
    k_nope, v = kv[..., :MLA_NOPE], kv[..., MLA_NOPE:]

    inv_freq = ROPE_THETA ** (-jnp.arange(0, MLA_ROPE, 2, dtype=jnp.float32) / MLA_ROPE)
    ang = positions.astype(jnp.float32)[..., None] * inv_freq
    cos, sin = jnp.cos(ang), jnp.sin(ang)
    q_pe = rope(q_pe, cos[:, :, None, :], sin[:, :, None, :])
    k_pe = rope(k_pe_raw, cos, sin)

    scale = (MLA_NOPE + MLA_ROPE) ** -0.5
    key_chunk = jnp.arange(S) // CHUNK

    def block(qi):
        start = qi * Q_BLOCK
        qn = lax.dynamic_slice_in_dim(q_nope, start, Q_BLOCK, axis=1)
        qp = lax.dynamic_slice_in_dim(q_pe, start, Q_BLOCK, axis=1)
        s = (jnp.einsum('bqhd,bkhd->bhqk', qn, k_nope)
             + jnp.einsum('bqhd,bkd->bhqk', qp, k_pe)).astype(jnp.float32) * scale
        q_chunk = (start + jnp.arange(Q_BLOCK)) // CHUNK
        mask = key_chunk[None, :] <= q_chunk[:, None]
        s = jnp.where(mask[None, None], s, NEG_INF)
        p = jax.nn.softmax(s, axis=-1).astype(v.dtype)
        return jnp.einsum('bhqk,bkhd->bqhd', p, v)

    o = lax.map(block, jnp.arange(S // Q_BLOCK))
    return jnp.moveaxis(o, 0, 1).reshape(B, S, MLA_OUT_WIDTH)


def chunk_attention(q, k, v, rel_bias):
    B, S = q.shape[:2]
    NC = S // CHUNK
    KB = CA_BAND * CHUNK
    q = q.reshape(B, NC, CHUNK, CA_HEADS, CA_HEAD_DIM)
    pad = ((0, 0), (CA_LEFT_CHUNKS, 0), (0, 0), (0, 0), (0, 0))
    kpad = jnp.pad(k.reshape(B, NC, CHUNK, CA_HEADS, CA_HEAD_DIM), pad)
    vpad = jnp.pad(v.reshape(B, NC, CHUNK, CA_HEADS, CA_HEAD_DIM), pad)
    idx = jnp.arange(NC)[:, None] + jnp.arange(CA_BAND)[None, :]
    kb = kpad[:, idx].reshape(B, NC, KB, CA_HEADS, CA_HEAD_DIM)
    vb = vpad[:, idx].reshape(B, NC, KB, CA_HEADS, CA_HEAD_DIM)

    s = jnp.einsum('bnqhd,bnkhd->bnhqk', q, kb).astype(jnp.float32) * CA_HEAD_DIM ** -0.5
    rel = CA_LEFT_CHUNKS * CHUNK + jnp.arange(CHUNK)[:, None] - jnp.arange(KB)[None, :]
    rel = jnp.clip(rel, -MAX_REL_DIST, MAX_REL_DIST) + MAX_REL_DIST
    bias = jnp.transpose(rel_bias[rel], (2, 0, 1)).astype(jnp.float32)
    s = s + bias[None, None]
    key_chunk = jnp.arange(NC)[:, None] - CA_LEFT_CHUNKS + jnp.arange(KB)[None, :] // CHUNK
    valid = key_chunk >= 0
    s = jnp.where(valid[None, :, None, None, :], s, NEG_INF)
    p = jax.nn.softmax(s, axis=-1).astype(vb.dtype)
    o = jnp.einsum('bnhqk,bnkhd->bnqhd', p, vb)
    return o.reshape(B, S, CA_WIDTH)


def setup_inputs(seed: int = 0) -> dict:
    key = jax.random.key(seed)
    ks = jax.random.split(key, 24)
    L, D = DEPTH, D_MODEL

    def w(k, shape, fan_in, mult=1.0):
        return jax.random.normal(k, shape, jnp.float32) * (mult * fan_in ** -0.5)

    def gain(k, shape):
        return 1.0 + 0.1 * jax.random.normal(k, shape, jnp.float32)

    offsets = jax.random.randint(ks[2], (BATCH, 1), 0, 64, dtype=jnp.int32) * CHUNK
    positions = offsets + jnp.arange(SEQ, dtype=jnp.int32)[None, :]
    return {
        "x": jax.random.normal(ks[0], (BATCH, SEQ, D), jnp.float32),
        "c": jax.random.normal(ks[1], (BATCH, D), jnp.float32),
        "positions": positions,
        "w_ada": w(ks[3], (L, D, ADA_WIDTH), D),
        "b_ada": 0.1 * jax.random.normal(ks[4], (L, ADA_WIDTH), jnp.float32),
        "ffn1_norm": gain(ks[5], (L, D)),
        "ffn1_w_in": w(ks[6], (L, D, 2 * D_FF), D),
        "ffn1_w_out": w(ks[7], (L, D_FF, D), D_FF),
        "mix_norm": gain(ks[8], (L, D)),
        "w_in": w(ks[9], (L, D, W_IN_COLS), D),
        "mla_q_norm": gain(ks[10], (L, MLA_Q_RANK)),
        "mla_w_uq": w(ks[11], (L, MLA_Q_RANK, MLA_HEADS * (MLA_NOPE + MLA_ROPE)), MLA_Q_RANK),
        "mla_kv_norm": gain(ks[12], (L, MLA_KV_RANK)),
        "mla_w_ukv": w(ks[13], (L, MLA_KV_RANK, MLA_HEADS * (MLA_NOPE + MLA_V)), MLA_KV_RANK),
        "rel_bias": 0.5 * jax.random.normal(ks[14], (L, 2 * MAX_REL_DIST + 1, CA_HEADS), jnp.float32),
        "w_branch_a": w(ks[15], (L, MLA_OUT_WIDTH, D), MLA_OUT_WIDTH),
        "w_branch_b": w(ks[16], (L, CA_WIDTH, D), CA_WIDTH),
        "w_out": w(ks[17], (L, D, D), D),
        "ffn2_norm": gain(ks[18], (L, D)),
        "ffn2_w_in": w(ks[19], (L, D, 2 * D_FF), D),
        "ffn2_w_out": w(ks[20], (L, D_FF, D), D_FF),
        "final_norm": gain(ks[21], (D,)),
    }


def reference(x, c, positions, w_ada, b_ada, ffn1_norm, ffn1_w_in, ffn1_w_out,
              mix_norm, w_in, mla_q_norm, mla_w_uq, mla_kv_norm, mla_w_ukv, rel_bias,
              w_branch_a, w_branch_b, w_out, ffn2_norm, ffn2_w_in, ffn2_w_out, final_norm):
    c_act = jax.nn.silu(c)
    splits = []
    acc = 0
    for width in (MLA_Q_RANK, MLA_KV_RANK, MLA_ROPE, CA_WIDTH, CA_WIDTH, CA_WIDTH, D_MODEL):
        acc += width
        splits.append(acc)

    for l in range(DEPTH):
        ada = c_act @ w_ada[l] + b_ada[l]
        (sh1, sc1, g1, sh2, sc2, g2, sh3, sc3, g3) = jnp.split(ada, 3 * ADA_SUBLAYERS, axis=-1)

        h = modulate(rmsnorm(x, ffn1_norm[l]), sh1, sc1)
        x = x + FFN_RES_WEIGHT * g1[:, None, :] * swiglu(h, ffn1_w_in[l], ffn1_w_out[l])

        h = modulate(rmsnorm(x, mix_norm[l]), sh2, sc2)
        z = h @ w_in[l]
        q_lat, kv_lat, k_pe_raw, ca_q, ca_k, ca_v, gate_a, gate_b = jnp.split(z, splits, axis=-1)
        y_a = mla_attention(q_lat, kv_lat, k_pe_raw, positions, mla_q_norm[l], mla_w_uq[l],
                            mla_kv_norm[l], mla_w_ukv[l]) @ w_branch_a[l]
        B, S = ca_q.shape[:2]
        shp = (B, S, CA_HEADS, CA_HEAD_DIM)
        y_b = chunk_attention(ca_q.reshape(shp), ca_k.reshape(shp), ca_v.reshape(shp),
                              rel_bias[l]) @ w_branch_b[l]
        merged = jax.nn.sigmoid(gate_a) * y_a + jax.nn.sigmoid(gate_b) * y_b
        x = x + g2[:, None, :] * (merged @ w_out[l])

        h = modulate(rmsnorm(x, ffn2_norm[l]), sh3, sc3)
        x = x + FFN_RES_WEIGHT * g3[:, None, :] * swiglu(h, ffn2_w_in[l], ffn2_w_out[l])

    return rmsnorm(x, final_norm)
```

```cpp
#include <hip/hip_runtime.h>
#include <hip/hip_cooperative_groups.h>
#include <cstdio>
#include <cstdint>
#include <cstring>
namespace cg = cooperative_groups;

typedef unsigned short bf16_t;
typedef short bf16x8 __attribute__((ext_vector_type(8)));
typedef short s16x4 __attribute__((ext_vector_type(4)));
typedef float f32x4 __attribute__((ext_vector_type(4)));
typedef float f32x16 __attribute__((ext_vector_type(16)));
typedef float f32x8 __attribute__((ext_vector_type(8)));
typedef float f32x2 __attribute__((ext_vector_type(2)));
#define MX3(a, b, c) __builtin_fmaxf(__builtin_fmaxf((a), (b)), (c))
typedef unsigned u32x4 __attribute__((ext_vector_type(4)));
typedef unsigned u32x2 __attribute__((ext_vector_type(2)));
#define LAS __attribute__((address_space(3)))
#define DI __device__ __forceinline__

constexpr int T = 32768, S = 4096, D = 1024, DFF = 2816, NADA = 9216;
constexpr int LDS_BYTES = 131072 + 16 + 9216;
constexpr float EPSV = 1e-6f;
constexpr float LOG2E = 1.4426950408889634f;
constexpr float QSCALE = 0.10206207261596575f * 1.4426950408889634f;
constexpr float CASCALE = 0.125f * 1.4426950408889634f;

struct WDesc { const float* src; bf16_t* dst; const float* gain; int K, N, nslots, mode, start, pad; };
struct Params {
    const float *x, *c; const int* pos; const float *w_ada, *b_ada, *ffn1_norm, *mix_norm, *ffn2_norm, *final_norm, *rel_bias;
    float* out;
    WDesc wd[10];
    bf16_t *wt1i, *wt1o, *wtin, *wtuq, *wtukv, *wtba, *wtbb, *wto, *wt2i, *wt2o;
    float *ada, *rope, *ssq, *sskv;
    bf16_t *H, *ACT, *GATES, *QM, *KVM, *ZR, *OA, *OB, *KPE, *M, *XB; float* TMP;
    unsigned* bar; float* exch; bf16_t* H3;
    int n_trans, pad0;
};

DI unsigned cvt_pk_bf16(float lo, float hi) { unsigned r; asm volatile("v_cvt_pk_bf16_f32 %0, %1, %2" : "=v"(r) : "v"(lo), "v"(hi)); return r; }
DI float bf2f(unsigned short v) { return __uint_as_float(((unsigned)v) << 16); }
DI float bflo(unsigned w) { return __uint_as_float(w << 16); }
DI float bfhi(unsigned w) { return __uint_as_float(w & 0xffff0000u); }
DI int perm32(int rho) { const int n = rho >> 4, i = rho & 15; return 8 * (i >> 2) + 4 * n + (i & 3); }

constexpr int HTB = 128 * 64 * 2;
DI int lds_byte(int r, int c) { const int st = (r >> 4) * 2 + (c >> 5), rr = r & 15, cc = c & 31, ob = rr * 64 + cc * 2; return st * 1024 + (ob ^ (((ob >> 9) & 1) << 5)); }
DI void stage_rc(int b, int& R, int& C) { const int st = b / 1024, sb = b % 1024, swz = sb ^ (((sb >> 9) & 1) << 5); R = (st >> 1) * 16 + swz / 64; C = (st & 1) * 32 + (swz % 64) / 2; }

DI void tile_map(int L, int nM, int nN, int& pm, int& pn) {
    const int nwg = nM * nN; int wgid = L;
    { const int q = nwg / 8, r = nwg % 8, xcd = wgid % 8, off = wgid / 8; wgid = (xcd < r ? xcd * (q + 1) : r * (q + 1) + (xcd - r) * q) + off; }
    constexpr int WGM = 4;
    const int nig = WGM * nN, gid = wgid / nig, fm = gid * WGM, gsz = (nM - fm) < WGM ? (nM - fm) : WGM;
    pm = fm + ((wgid % nig) % gsz); pn = (wgid % nig) / gsz;
}

enum { E_SWIGLU = 0, E_RESID = 1, E_Z = 2, E_QUP = 3, E_KVUP = 4, E_BRA = 5, E_BRB = 6, E_RESIDB = 7 };
struct EpiArgs { const float* resid; const float* gate; float gs; const float* ngain; const float* nsc; const float* nsh; bf16_t* nout_h; float* nout_f; float* exch; unsigned* flags; };

DI float swi_f(float g, float u) { return (g * u) * __builtin_amdgcn_rcpf(1.f + __builtin_amdgcn_exp2f(-g)); }
DI float sigm_f(float g) { return __builtin_amdgcn_rcpf(1.f + __builtin_amdgcn_exp2f(-g)); }

template <int EPI, int FUSE = 0>
DI void gemm_phase(LAS unsigned char* lds, const Params& p, const bf16_t* A, int lda, const bf16_t* Bt, int K, int nM, int nN, int L0, int Lend, int G, const EpiArgs ea,
                   const bf16_t* A2 = nullptr, const bf16_t* Bt2 = nullptr) {
    constexpr bool DUAL = (EPI == E_BRB);
    int tid_ = threadIdx.x; asm volatile("" : "+v"(tid_));
    const int tid = tid_, wid = __builtin_amdgcn_readfirstlane(tid >> 6), lane = tid & 63, wr = wid >> 2, wc = wid & 3, fr = lane & 15, fq = lane >> 4;
    const int nt = K / 64;
    if (L0 >= Lend) return;
    unsigned voffA[2], voffB[2];
#pragma unroll
    for (int i = 0; i < 2; ++i) { int R, C; stage_rc(tid * 16 + i * 8192, R, C); voffA[i] = (unsigned)(R * lda + C); voffB[i] = (unsigned)(R * K + C); }
    int L = L0, pm, pn;
    if constexpr (FUSE > 0) { pm = L >> 2; pn = L & 3; } else tile_map(L, nM, nN, pm, pn);
    const bf16_t* Ab = A + (size_t)pm * 256 * lda;
    const bf16_t* Bb = Bt + (size_t)pn * 256 * K;
    const unsigned ldsw = (unsigned)wid * 1024u;
    const int aoff = lds_byte(wr * 64 + fr, fq * 8), boff = lds_byte(wc * 32 + fr, fq * 8);
#define G_SA(b, h) (((b) * 2 + (h)) * HTB)
#define G_SB(b, h) ((4 + (b) * 2 + (h)) * HTB)
#define G_STAGE(b, kt) do { _Pragma("unroll") for (int h_ = 0; h_ < 2; ++h_) { _Pragma("unroll") for (int i_ = 0; i_ < 2; ++i_) { \
        __builtin_amdgcn_global_load_lds((const unsigned*)(Bb + (size_t)h_ * 128 * K + (kt) * 64 + voffB[i_]), (LAS unsigned*)(lds + G_SB(b, h_) + ldsw + i_ * 8192), 16, 0, 0); \
        __builtin_amdgcn_global_load_lds((const unsigned*)(Ab + (size_t)h_ * 128 * lda + (kt) * 64 + voffA[i_]), (LAS unsigned*)(lds + G_SA(b, h_) + ldsw + i_ * 8192), 16, 0, 0); } } } while (0)
#define G_LDA(dst, b, h) do { _Pragma("unroll") for (int m = 0; m < 4; ++m) _Pragma("unroll") for (int k = 0; k < 2; ++k) dst[m][k] = *(const LAS bf16x8*)(lds + G_SA(b, h) + aoff + m * 2048 + k * 1024); } while (0)
#define G_LDB(dst, b, h) do { _Pragma("unroll") for (int n = 0; n < 2; ++n) _Pragma("unroll") for (int k = 0; k < 2; ++k) dst[n][k] = *(const LAS bf16x8*)(lds + G_SB(b, h) + boff + n * 2048 + k * 1024); } while (0)
#define G_MMA(ai, bj, At, Bf) do { _Pragma("unroll") for (int m = 0; m < 4; ++m) _Pragma("unroll") for (int n = 0; n < 2; ++n) _Pragma("unroll") for (int k = 0; k < 2; ++k) \
        acc[ai][bj][m][n] = __builtin_amdgcn_mfma_f32_16x16x32_bf16(Bf[n][k], At[m][k], acc[ai][bj][m][n], 0, 0, 0); } while (0)
#define G_STG_A(b, h, kt) do { const bf16_t* ub_ = Ab + (size_t)(h) * 128 * lda + (kt) * 64; asm volatile("" : "+s"(ub_)); _Pragma("unroll") for (int i_ = 0; i_ < 2; ++i_) \
        __builtin_amdgcn_global_load_lds((const unsigned*)(ub_ + voffA[i_]), (LAS unsigned*)(lds + G_SA(b, h) + ldsw + i_ * 8192), 16, 0, 0); } while (0)
#define G_STG_B(b, h, kt) do { const bf16_t* ub_ = Bb + (size_t)(h) * 128 * K + (kt) * 64; asm volatile("" : "+s"(ub_)); _Pragma("unroll") for (int i_ = 0; i_ < 2; ++i_) \
        __builtin_amdgcn_global_load_lds((const unsigned*)(ub_ + voffB[i_]), (LAS unsigned*)(lds + G_SB(b, h) + ldsw + i_ * 8192), 16, 0, 0); } while (0)
#define G_MMAP(ai, bj, At, Bf) do { __builtin_amdgcn_s_setprio(1); G_MMA(ai, bj, At, Bf); __builtin_amdgcn_s_setprio(0); } while (0)
#define WAIT_V(n) asm volatile("s_waitcnt vmcnt(" #n ")" ::: "memory")
#define WAIT_L(n) asm volatile("s_waitcnt lgkmcnt(" #n ")" ::: "memory")
#define BAR __builtin_amdgcn_s_barrier()
#define SCHED __builtin_amdgcn_sched_barrier(0)
#define G_STGP(bufoff, gp, voff) do { const bf16_t* ub_ = (gp); asm volatile("" : "+s"(ub_)); _Pragma("unroll") for (int i_ = 0; i_ < 2; ++i_) \
        __builtin_amdgcn_global_load_lds((const unsigned*)(ub_ + (voff)[i_]), (LAS unsigned*)(lds + (bufoff) + ldsw + i_ * 8192), 16, 0, 0); } while (0)
    f32x4 acc[2][2][4][2];
#define G_ZERO() do { _Pragma("unroll") for (int a = 0; a < 2; ++a) _Pragma("unroll") for (int b = 0; b < 2; ++b) _Pragma("unroll") for (int m = 0; m < 4; ++m) _Pragma("unroll") for (int n = 0; n < 2; ++n) acc[a][b][m][n] = (f32x4){0.f, 0.f, 0.f, 0.f}; } while (0)
    G_ZERO();
    auto epilogue = [&](int pm, int pn) {
    const int bidx = (pm * 256) >> 12;
    f32x4 hz[2][2] = {};
    if constexpr (EPI == E_RESID || EPI == E_RESIDB) {
#pragma unroll
        for (int bj = 0; bj < 2; ++bj) { const int col = pn * 256 + bj * 128 + wc * 32 + 8 * fq; const float gsc = ea.gs;
            const f32x4 t0 = *(const f32x4*)(ea.gate + bidx * NADA + col), t1 = *(const f32x4*)(ea.gate + bidx * NADA + col + 4);
            hz[bj][0] = (f32x4){t0[0] * gsc, t0[1] * gsc, t0[2] * gsc, t0[3] * gsc}; hz[bj][1] = (f32x4){t1[0] * gsc, t1[1] * gsc, t1[2] * gsc, t1[3] * gsc}; }
    }
#pragma unroll
    for (int ai = 0; ai < 2; ++ai)
#pragma unroll
        for (int m = 0; m < 4; ++m) {
            const int row = pm * 256 + ai * 128 + wr * 64 + m * 16 + fr;
            if constexpr (EPI == E_SWIGLU) {
                const int actcol = pn * 128 + wc * 32 + 8 * fq;
                const f32x4 g0 = acc[ai][0][m][0], g1 = acc[ai][0][m][1], u0 = acc[ai][1][m][0], u1 = acc[ai][1][m][1];
                u32x4 w;
                w.x = cvt_pk_bf16(swi_f(g0[0], u0[0]), swi_f(g0[1], u0[1])); w.y = cvt_pk_bf16(swi_f(g0[2], u0[2]), swi_f(g0[3], u0[3]));
                w.z = cvt_pk_bf16(swi_f(g1[0], u1[0]), swi_f(g1[1], u1[1])); w.w = cvt_pk_bf16(swi_f(g1[2], u1[2]), swi_f(g1[3], u1[3]));
                *(u32x4*)(p.ACT + (size_t)row * DFF + actcol) = w;
            } else if constexpr (EPI == E_Z) {
                float ss = 0.f;
#pragma unroll
                for (int bj = 0; bj < 2; ++bj) {
                    const int col = pn * 256 + bj * 128 + wc * 32 + 8 * fq;
                    f32x4 v0 = acc[ai][bj][m][0], v1 = acc[ai][bj][m][1];
                    if (pn == 8 || (pn == 9 && bj == 0)) ss += (v0[0] * v0[0] + v0[1] * v0[1]) + (v0[2] * v0[2] + v0[3] * v0[3]) + (v1[0] * v1[0] + v1[1] * v1[1]) + (v1[2] * v1[2] + v1[3] * v1[3]);
                    bf16_t* dst;
                    if (pn < 8) {
#pragma unroll
                        for (int j = 0; j < 4; ++j) { v0[j] = sigm_f(v0[j]); v1[j] = sigm_f(v1[j]); }
                        dst = p.GATES + (size_t)row * 2048 + col;
                    } else {
                        if (pn == 10 || pn == 11) { v0 = v0 * CASCALE; v1 = v1 * CASCALE; }
                        dst = p.ZR + (size_t)row * 2048 + (col - 2048);
                    }
                    u32x4 w; w.x = cvt_pk_bf16(v0[0], v0[1]); w.y = cvt_pk_bf16(v0[2], v0[3]); w.z = cvt_pk_bf16(v1[0], v1[1]); w.w = cvt_pk_bf16(v1[2], v1[3]);
                    *(u32x4*)dst = w;
                }
                if (pn == 8 || pn == 9) {
                    ss += __shfl_xor(ss, 16); ss += __shfl_xor(ss, 32);
                    if (fq == 0) unsafeAtomicAdd((pn == 8 ? p.ssq : p.sskv) + row, ss);
                }
            } else {
                float rs = 1.f;
                if constexpr (EPI == E_QUP) rs = rsqrtf(p.ssq[row] * (1.f / 256.f) + EPSV) * QSCALE;
                if constexpr (EPI == E_KVUP) rs = rsqrtf(p.sskv[row] * (1.f / 128.f) + EPSV);
#pragma unroll
                for (int bj = 0; bj < 2; ++bj) {
                    const int col = pn * 256 + bj * 128 + wc * 32 + 8 * fq;
                    const f32x4 v0 = acc[ai][bj][m][0], v1 = acc[ai][bj][m][1];
                    if constexpr (EPI == E_RESID || EPI == E_RESIDB) {
                        f32x4 r0, r1;
                        if constexpr (EPI == E_RESID) { r0 = *(const f32x4*)(ea.resid + (size_t)row * D + col); r1 = *(const f32x4*)(ea.resid + (size_t)row * D + col + 4); }
                        else { const u32x4 rw = *(const u32x4*)(p.XB + (size_t)row * D + col);
                            r0 = (f32x4){bflo(rw.x), bfhi(rw.x), bflo(rw.y), bfhi(rw.y)}; r1 = (f32x4){bflo(rw.z), bfhi(rw.z), bflo(rw.w), bfhi(rw.w)}; }
                        const f32x4 o0 = r0 + hz[bj][0] * v0, o1 = r1 + hz[bj][1] * v1;
                        u32x4 w; w.x = cvt_pk_bf16(o0[0], o0[1]); w.y = cvt_pk_bf16(o0[2], o0[3]); w.z = cvt_pk_bf16(o1[0], o1[1]); w.w = cvt_pk_bf16(o1[2], o1[3]);
                        *(u32x4*)(p.XB + (size_t)row * D + col) = w;
                    } else if constexpr (EPI == E_QUP) {
                        u32x4 w; w.x = cvt_pk_bf16(v0[0] * rs, v0[1] * rs); w.y = cvt_pk_bf16(v0[2] * rs, v0[3] * rs); w.z = cvt_pk_bf16(v1[0] * rs, v1[1] * rs); w.w = cvt_pk_bf16(v1[2] * rs, v1[3] * rs);
                        *(u32x4*)(p.QM + (size_t)row * 768 + col) = w;
                    } else if constexpr (EPI == E_KVUP) {
                        u32x4 w; w.x = cvt_pk_bf16(v0[0] * rs, v0[1] * rs); w.y = cvt_pk_bf16(v0[2] * rs, v0[3] * rs); w.z = cvt_pk_bf16(v1[0] * rs, v1[1] * rs); w.w = cvt_pk_bf16(v1[2] * rs, v1[3] * rs);
                        *(u32x4*)(p.KVM + (size_t)row * 1024 + col) = w;
                    } else if constexpr (EPI == E_BRB) {
                        const u32x4 gw = *(const u32x4*)(p.GATES + (size_t)row * 2048 + 1024 + col);
                        u32x4 w;
#define G_CLB(x) fmaxf((x), 1e-20f)
                        w.x = cvt_pk_bf16(G_CLB(bflo(gw.x)) * v0[0], G_CLB(bfhi(gw.x)) * v0[1]); w.y = cvt_pk_bf16(G_CLB(bflo(gw.y)) * v0[2], G_CLB(bfhi(gw.y)) * v0[3]);
                        w.z = cvt_pk_bf16(G_CLB(bflo(gw.z)) * v1[0], G_CLB(bfhi(gw.z)) * v1[1]); w.w = cvt_pk_bf16(G_CLB(bflo(gw.w)) * v1[2], G_CLB(bfhi(gw.w)) * v1[3]);
#undef G_CLB
                        *(u32x4*)(p.M + (size_t)row * D + col) = w;
                    }
                }
            }
        }
    };
    auto epilogue_fused = [&](int pm, int pn) {
        const int u = pn & 1, half = pn >> 1;
        const int bidx = (pm * 256) >> 12;
        LAS float* rs8 = (LAS float*)(lds + 131088);
        LAS float* rstd_l = rs8 + 2048;
        f32x4 hz[2][2];
#pragma unroll
        for (int bj = 0; bj < 2; ++bj) { const int col = pn * 256 + bj * 128 + wc * 32 + 8 * fq; const float gsc = ea.gs;
            const f32x4 t0 = *(const f32x4*)(ea.gate + bidx * NADA + col), t1 = *(const f32x4*)(ea.gate + bidx * NADA + col + 4);
            hz[bj][0] = (f32x4){t0[0] * gsc, t0[1] * gsc, t0[2] * gsc, t0[3] * gsc}; hz[bj][1] = (f32x4){t1[0] * gsc, t1[1] * gsc, t1[2] * gsc, t1[3] * gsc}; }
#pragma unroll
        for (int ai = 0; ai < 2; ++ai)
#pragma unroll
            for (int m = 0; m < 4; ++m) {
                const int row_l = ai * 128 + wr * 64 + m * 16 + fr, row = pm * 256 + row_l;
                float ss = 0.f;
#pragma unroll
                for (int bj = 0; bj < 2; ++bj) {
                    const int col = pn * 256 + bj * 128 + wc * 32 + 8 * fq;
                    f32x4 r0, r1;
                    if constexpr (EPI == E_RESID) { r0 = *(const f32x4*)(ea.resid + (size_t)row * D + col); r1 = *(const f32x4*)(ea.resid + (size_t)row * D + col + 4); }
                    else { const u32x4 rw = *(const u32x4*)(p.XB + (size_t)row * D + col);
                        r0 = (f32x4){bflo(rw.x), bfhi(rw.x), bflo(rw.y), bfhi(rw.y)}; r1 = (f32x4){bflo(rw.z), bfhi(rw.z), bflo(rw.w), bfhi(rw.w)}; }
                    const f32x4 o0 = r0 + hz[bj][0] * acc[ai][bj][m][0], o1 = r1 + hz[bj][1] * acc[ai][bj][m][1];
                    if (FUSE == 1 || u == 0) { u32x4 w; w.x = cvt_pk_bf16(o0[0], o0[1]); w.y = cvt_pk_bf16(o0[2], o0[3]); w.z = cvt_pk_bf16(o1[0], o1[1]); w.w = cvt_pk_bf16(o1[2], o1[3]);
                        *(u32x4*)(p.XB + (size_t)row * D + col) = w; }
                    ss += (o0[0] * o0[0] + o0[1] * o0[1]) + (o0[2] * o0[2] + o0[3] * o0[3]) + (o1[0] * o1[0] + o1[1] * o1[1]) + (o1[2] * o1[2] + o1[3] * o1[3]);
                    acc[ai][bj][m][0] = o0; acc[ai][bj][m][1] = o1;
                }
                ss += __shfl_xor(ss, 16); ss += __shfl_xor(ss, 32);
                if (fq == 0) rs8[(u * 4 + wc) * 256 + row_l] = ss;
            }
        if (u == 0) return;
        WAIT_L(0); BAR;
        int tid = threadIdx.x; asm volatile("" : "+v"(tid));
        float own = 0.f;
        if (tid < 256) {
#pragma unroll
            for (int k = 0; k < 8; ++k) own += rs8[k * 256 + tid];
            __hip_atomic_store(ea.exch + (size_t)(pm * 2 + half) * 256 + tid, own, __ATOMIC_RELAXED, __HIP_MEMORY_SCOPE_AGENT);
        }
        WAIT_V(0); BAR;
        if (tid == 0) {
            __hip_atomic_store(ea.flags + pm * 2 + half, 1u, __ATOMIC_RELAXED, __HIP_MEMORY_SCOPE_AGENT);
            unsigned sp = 0u;
            while (__hip_atomic_load(ea.flags + pm * 2 + (half ^ 1), __ATOMIC_RELAXED, __HIP_MEMORY_SCOPE_AGENT) == 0u) { __builtin_amdgcn_s_sleep(2); if (++sp > (1u << 22)) break; }
        }
        asm volatile("s_waitcnt vmcnt(0) lgkmcnt(0)" ::: "memory"); BAR; asm volatile("" ::: "memory");
        if (tid < 256) {
            const float oth = __hip_atomic_load(ea.exch + (size_t)(pm * 2 + (half ^ 1)) * 256 + tid, __ATOMIC_RELAXED, __HIP_MEMORY_SCOPE_AGENT);
            rstd_l[tid] = rsqrtf((own + oth) * (1.f / 1024.f) + EPSV);
        }
        asm volatile("s_waitcnt vmcnt(0) lgkmcnt(0)" ::: "memory"); BAR; asm volatile("" ::: "memory");
#pragma unroll
        for (int v = 1; v >= 0; --v) {
            const int pnv = pn - 1 + v;
#pragma unroll
            for (int bj = 0; bj < 2; ++bj) {
                const int col = pnv * 256 + bj * 128 + wc * 32 + 8 * fq;
                f32x4 Gn[2], Sn[2];
#pragma unroll
                for (int q = 0; q < 2; ++q) { Gn[q] = *(const f32x4*)(ea.ngain + col + 4 * q); Sn[q] = (f32x4){0.f, 0.f, 0.f, 0.f};
                    if constexpr (FUSE == 1) { Gn[q] = Gn[q] * (*(const f32x4*)(ea.nsc + bidx * NADA + col + 4 * q) + 1.f); Sn[q] = *(const f32x4*)(ea.nsh + bidx * NADA + col + 4 * q); } }
#pragma unroll
                for (int ai = 0; ai < 2; ++ai)
#pragma unroll
                    for (int m = 0; m < 4; ++m) {
                        const int row_l = ai * 128 + wr * 64 + m * 16 + fr, row = pm * 256 + row_l;
                        const float rs = rstd_l[row_l];
                        f32x4 x0, x1;
                        if (v == 1) { x0 = acc[ai][bj][m][0]; x1 = acc[ai][bj][m][1]; }
                        else { const u32x4 rw = *(const u32x4*)(p.XB + (size_t)row * D + col);
                            x0 = (f32x4){bflo(rw.x), bfhi(rw.x), bflo(rw.y), bfhi(rw.y)}; x1 = (f32x4){bflo(rw.z), bfhi(rw.z), bflo(rw.w), bfhi(rw.w)}; }
                        const f32x4 y0 = x0 * rs * Gn[0] + Sn[0], y1 = x1 * rs * Gn[1] + Sn[1];
                        if constexpr (FUSE == 1) { u32x4 w; w.x = cvt_pk_bf16(y0[0], y0[1]); w.y = cvt_pk_bf16(y0[2], y0[3]); w.z = cvt_pk_bf16(y1[0], y1[1]); w.w = cvt_pk_bf16(y1[2], y1[3]);
                            *(u32x4*)(ea.nout_h + (size_t)row * D + col) = w; }
                        else { *(f32x4*)(ea.nout_f + (size_t)row * D + col) = y0; *(f32x4*)(ea.nout_f + (size_t)row * D + col + 4) = y1; }
                    }
            }
        }
    };
    auto rescale = [&](int pm, int pn) {
#pragma unroll
            for (int ai = 0; ai < 2; ++ai)
#pragma unroll
                for (int m = 0; m < 4; ++m) {
                    const int row = pm * 256 + ai * 128 + wr * 64 + m * 16 + fr;
#pragma unroll
                    for (int bj = 0; bj < 2; ++bj) {
                        const int col = pn * 256 + bj * 128 + wc * 32 + 8 * fq;
                        const u32x4 ga = *(const u32x4*)(p.GATES + (size_t)row * 2048 + col), gb = *(const u32x4*)(p.GATES + (size_t)row * 2048 + 1024 + col);
#define G_RATIO(x, y) ((x) * __builtin_amdgcn_rcpf(fmaxf((y), 1e-20f)))
                        acc[ai][bj][m][0][0] *= G_RATIO(bflo(ga.x), bflo(gb.x)); acc[ai][bj][m][0][1] *= G_RATIO(bfhi(ga.x), bfhi(gb.x));
                        acc[ai][bj][m][0][2] *= G_RATIO(bflo(ga.y), bflo(gb.y)); acc[ai][bj][m][0][3] *= G_RATIO(bfhi(ga.y), bfhi(gb.y));
                        acc[ai][bj][m][1][0] *= G_RATIO(bflo(ga.z), bflo(gb.z)); acc[ai][bj][m][1][1] *= G_RATIO(bfhi(ga.z), bfhi(gb.z));
                        acc[ai][bj][m][1][2] *= G_RATIO(bflo(ga.w), bflo(gb.w)); acc[ai][bj][m][1][3] *= G_RATIO(bfhi(ga.w), bfhi(gb.w));
                    }
                    if (m == 3) asm volatile("" ::: "memory");
                }

    };
    const size_t hsA = (size_t)128 * lda, hsB = (size_t)128 * K;
    const bf16_t* cA = Ab; const bf16_t* cB = Bb;
    G_STGP(G_SB(0, 0), cB, voffB); G_STGP(G_SB(0, 1), cB + hsB, voffB); G_STGP(G_SA(0, 0), cA, voffA); G_STGP(G_SA(0, 1), cA + hsA, voffA);
    if (wr == 1) BAR;
    WAIT_V(2); BAR;
    G_STGP(G_SB(1, 0), cB + 64, voffB); G_STGP(G_SA(1, 0), cA + 64, voffA); G_STGP(G_SB(1, 1), cB + hsB + 64, voffB);
    WAIT_V(6); BAR;
    int seg = 0;
    bf16x8 At[4][2], B0[2][2], B1[2][2];
    for (;;) {
        const bool mid = DUAL && seg == 0;
        const bool has_next_unit = (L + G < Lend);
        const bool has_next = mid || has_next_unit;
        int pmn = pm, pnn = pn;
        const bf16_t* nA = cA; const bf16_t* nB = cB;
        if (mid) { nA = A2 + (size_t)pm * 256 * lda; nB = Bt2 + (size_t)pn * 256 * K; }
        else if (has_next_unit) { if constexpr (FUSE > 0) { pmn = (L + G) >> 2; pnn = (L + G) & 3; } else tile_map(L + G, nM, nN, pmn, pnn); nA = A + (size_t)pmn * 256 * lda; nB = Bt + (size_t)pnn * 256 * K; }
        for (int t = 0; t < nt; t += 2) {
            const bool last = (t == nt - 2);
            const bf16_t* a1 = cA + (size_t)(t + 1) * 64;
            const bf16_t* a2 = last ? nA : cA + (size_t)(t + 2) * 64; const bf16_t* b2 = last ? nB : cB + (size_t)(t + 2) * 64;
            const bf16_t* a3 = a2 + 64; const bf16_t* b3 = b2 + 64;
            G_LDB(B0, 0, 0); G_LDB(B1, 0, 1); SCHED; G_LDA(At, 0, 0); G_STGP(G_SA(1, 1), a1 + hsA, voffA);
            WAIT_V(8); WAIT_L(0); BAR; G_MMAP(0, 0, At, B0); G_MMAP(0, 1, At, B1); BAR; SCHED;
            G_LDA(At, 0, 1); G_STGP(G_SB(0, 0), b2, voffB); G_STGP(G_SB(0, 1), b2 + hsB, voffB); G_STGP(G_SA(0, 0), a2, voffA);
            WAIT_V(8); WAIT_L(0); BAR; G_MMAP(1, 0, At, B0); G_MMAP(1, 1, At, B1); BAR; SCHED;
            G_LDB(B0, 1, 0); G_LDB(B1, 1, 1); SCHED; G_LDA(At, 1, 0); G_STGP(G_SA(0, 1), a2 + hsA, voffA);
            WAIT_V(8); WAIT_L(0); BAR; G_MMAP(0, 0, At, B0); G_MMAP(0, 1, At, B1); BAR; SCHED;
            G_LDA(At, 1, 1); G_STGP(G_SB(1, 0), b3, voffB); G_STGP(G_SB(1, 1), b3 + hsB, voffB); G_STGP(G_SA(1, 0), a3, voffA);
            WAIT_V(8); WAIT_L(0); BAR; G_MMAP(1, 0, At, B0); G_MMAP(1, 1, At, B1); BAR; SCHED;
        }
        if (wr == 0) BAR;
        if (mid) rescale(pm, pn); else { if constexpr (FUSE > 0) epilogue_fused(pm, pn); else epilogue(pm, pn); }
        if (!has_next) break;
        if (!mid) { G_ZERO(); pm = pmn; pn = pnn; L += G; }
        cA = nA; cB = nB; if (DUAL) seg ^= 1;
        if (wr == 1) BAR;
    }
    WAIT_V(0);
    BAR;
}

#define MFMA32(a, b, c) __builtin_amdgcn_mfma_f32_32x32x16_bf16(a, b, c, 0, 0, 0)
DI int crow(int r, int hi) { return (r & 3) + 8 * (r >> 2) + 4 * hi; }
typedef short v4i16_t __attribute__((ext_vector_type(4)));
DI s16x4 vtr(const LAS unsigned char* pp) { return __builtin_bit_cast(s16x4, __builtin_amdgcn_ds_read_tr16_b64_v4i16((LAS v4i16_t*)pp)); }

constexpr int A_KB = 12288, A_VOFF = 2 * A_KB, A_VB = 8192, A_BIAS = A_VOFF + 3 * A_VB;

template <int MODE>
DI void attn_item(LAS unsigned char* lds, const Params& p, int b, int h, int qb) {
    constexpr int NKS = MODE == 0 ? 6 : 4;
    int tid_ = threadIdx.x; asm volatile("" : "+v"(tid_));
    const int tid = tid_, lane = tid & 63, wid = __builtin_amdgcn_readfirstlane(tid >> 6), r32 = lane & 31, hi = lane >> 5;
    const size_t rowbase = (size_t)b * S;
    const int q0 = qb * 256;
    const size_t qrow = rowbase + q0 + wid * 32 + r32;
    const int cw = qb * 4 + (wid >> 1);
    const int t0 = MODE == 0 ? 0 : (qb * 4 - 8 > 0 ? qb * 4 - 8 : 0), t1 = qb * 4 + 3;
    bf16x8 qf[NKS];
    if constexpr (MODE == 0) {
        const bf16_t* src = p.QM + qrow * 768 + h * 96;
#pragma unroll
        for (int ks = 0; ks < 6; ++ks) qf[ks] = *(const bf16x8*)(src + ks * 16 + hi * 8);
        const float* rp = p.rope + qrow * 32 + 8 * hi;
        const f32x4 c0 = *(const f32x4*)(rp), c1 = *(const f32x4*)(rp + 4), s0 = *(const f32x4*)(rp + 16), s1 = *(const f32x4*)(rp + 20);
        bf16x8 a = qf[4], bq = qf[5], oa, ob;
#pragma unroll
        for (int j = 0; j < 8; ++j) {
            const float x1 = bf2f((unsigned short)a[j]), x2 = bf2f((unsigned short)bq[j]);
            const float cc = j < 4 ? c0[j & 3] : c1[j & 3], sn = j < 4 ? s0[j & 3] : s1[j & 3];
            const float y1 = x1 * cc - x2 * sn, y2 = x1 * sn + x2 * cc;
            oa[j] = (short)(cvt_pk_bf16(y1, 0.f) & 0xffffu); ob[j] = (short)(cvt_pk_bf16(y2, 0.f) & 0xffffu);
        }
        qf[4] = oa; qf[5] = ob;
    } else {
        const bf16_t* src = p.ZR + qrow * 2048 + 512 + h * 64;
#pragma unroll
        for (int ks = 0; ks < 4; ++ks) qf[ks] = *(const bf16x8*)(src + ks * 16 + hi * 8);
        float* bl = (float*)(lds + A_BIAS);
        for (int i = tid; i < 640; i += 512) bl[i] = p.rel_bias[(i > 512 ? 512 : i) * 8 + h] * LOG2E;
    }
    const int lkey = tid >> 3, lch = tid & 7;
    const bf16_t *ksrc, *vsrc, *pesrc = nullptr; size_t kstride;
    if constexpr (MODE == 0) {
        ksrc = p.KVM + rowbase * 1024 + (size_t)lkey * 1024 + h * 128 + lch * 8; vsrc = ksrc + 64; kstride = 1024;
        pesrc = p.KPE + rowbase * 32 + (size_t)(tid >> 2) * 32 + (tid & 3) * 8;
    } else {
        ksrc = p.ZR + rowbase * 2048 + (size_t)lkey * 2048 + 1024 + h * 64 + lch * 8; vsrc = ksrc + 512; kstride = 2048;
    }
    const int kdst = lch * 1024 + lkey * 16, vdst = A_VOFF + (lch >> 2) * 4096 + lkey * 64 + (lch & 3) * 16;
    const int pedst = (8 + (tid & 3)) * 1024 + (tid >> 2) * 16;
    u32x4 kreg, vreg, pereg;
#define A_LOAD(t) do { kreg = *(const u32x4*)(ksrc + (size_t)(t) * 64 * kstride); vreg = *(const u32x4*)(vsrc + (size_t)(t) * 64 * kstride); \
        if (MODE == 0 && tid < 256) pereg = *(const u32x4*)(pesrc + (size_t)(t) * 64 * 32); } while (0)
#define A_STORE(buf, vs) do { *(LAS u32x4*)(lds + (buf) * A_KB + kdst) = kreg; *(LAS u32x4*)(lds + (vs) * A_VB + vdst) = vreg; \
        if (MODE == 0 && tid < 256) *(LAS u32x4*)(lds + (buf) * A_KB + pedst) = pereg; } while (0)
    float m_run = -1e30f, l_run = 0.f;
    f32x16 o0, o1;
#pragma unroll
    for (int r = 0; r < 16; ++r) { o0[r] = 0.f; o1[r] = 0.f; }
    const int kfo = hi * 1024 + r32 * 16;
    const int vfo = A_VOFF + ((lane >> 4) & 1) * 32 + (lane & 3) * 8 + (4 * hi + ((lane & 15) >> 2)) * 64;
    const float cbias = MODE == 1 ? p.rel_bias[512 * 8 + h] * LOG2E : 0.f;
    const int qi = 32 * (wid & 1) + r32;
    const bool lag = wid >= 4;
    u32x4 pw[4];
    bool pend = false; int pend_vs = 0;
    auto do_pv = [&](int vs) {
        const LAS unsigned char* vp = lds + vs * A_VB + vfo;
#pragma unroll
            for (int s = 0; s < 4; ++s) {
                const s16x4 a0 = vtr(vp + s * 1024), a1 = vtr(vp + s * 1024 + 512), b0 = vtr(vp + 4096 + s * 1024), b1 = vtr(vp + 4096 + s * 1024 + 512);
                const bf16x8 vf0 = (bf16x8){a0[0], a0[1], a0[2], a0[3], a1[0], a1[1], a1[2], a1[3]};
                const bf16x8 vf1 = (bf16x8){b0[0], b0[1], b0[2], b0[3], b1[0], b1[1], b1[2], b1[3]};
                const bf16x8 pf = __builtin_bit_cast(bf16x8, pw[s]);
                o0 = MFMA32(vf0, pf, o0); o1 = MFMA32(vf1, pf, o1);
            }
    };
    A_LOAD(t0); A_STORE(0, 0);
    __syncthreads();
    int vslot = 0;
    for (int t = t0; t <= t1; ++t) {
        const int cur = (t - t0) & 1;
        const int vnext = vslot == 2 ? 0 : vslot + 1;
        if (t < t1) A_LOAD(t + 1);
        if (pend) { do_pv(pend_vs); pend = false; }
        const bool vis = MODE == 0 ? (t <= cw) : (t <= cw && t >= cw - 8);
        if (vis) {
            const LAS unsigned char* kp = lds + cur * A_KB + kfo;
            f32x16 p0, p1;
            float cb_t = 0.f;
            bool biased = false;
            if constexpr (MODE == 1) {
                const int dt = cw - t;
                if (dt < 5) {
                    biased = true;
                    const LAS float* bp = (const LAS float*)(lds + A_BIAS) + (64 * dt + qi + 193 - 4 * hi);
#pragma unroll
                    for (int r = 0; r < 16; ++r) { const int c = (r & 3) + 8 * (r >> 2); p0[r] = bp[63 - c]; p1[r] = bp[31 - c]; }
                } else cb_t = cbias;
            }
            if (!biased) {
#pragma unroll
                for (int r = 0; r < 16; ++r) { p0[r] = 0.f; p1[r] = 0.f; }
            }
#pragma unroll
            for (int ks = 0; ks < NKS; ++ks) {
                const bf16x8 k0 = *(const LAS bf16x8*)(kp + ks * 2048), k1 = *(const LAS bf16x8*)(kp + ks * 2048 + 512);
                p0 = MFMA32(k0, qf[ks], p0); p1 = MFMA32(k1, qf[ks], p1);
            }
            float mxa = MX3(p0[0], p0[1], p1[0]), mxb = MX3(p0[2], p0[3], p1[1]); mxa = MX3(mxa, p1[2], p1[3]);
#pragma unroll
            for (int r = 4; r < 16; r += 4) { mxa = MX3(mxa, p0[r], p0[r + 1]); mxb = MX3(mxb, p0[r + 2], p0[r + 3]); mxa = MX3(mxa, p1[r], p1[r + 1]); mxb = MX3(mxb, p1[r + 2], p1[r + 3]); }
            float mx = fmaxf(mxa, mxb);
            { auto rr = __builtin_amdgcn_permlane32_swap(__float_as_uint(mx), __float_as_uint(mx), false, false); mx = fmaxf(__uint_as_float(rr[0]), __uint_as_float(rr[1])); }
            mx += cb_t;
            if (__any(mx - m_run > 8.f)) {
                const float m_new = fmaxf(m_run, mx);
                const float alpha = __builtin_amdgcn_exp2f(m_run - m_new);
                m_run = m_new; l_run *= alpha;
                o0 = o0 * alpha; o1 = o1 * alpha;
            }
            { const float negref = cb_t - m_run; p0 = p0 + negref; p1 = p1 + negref; }
#pragma unroll
            for (int r = 0; r < 16; ++r) { p0[r] = __builtin_amdgcn_exp2f(p0[r]); p1[r] = __builtin_amdgcn_exp2f(p1[r]); }
            { const f32x16 sv = p0 + p1; const f32x8 s8 = sv.lo + sv.hi; const f32x4 s4 = s8.lo + s8.hi; const f32x2 s2 = s4.lo + s4.hi; l_run += s2.x + s2.y; }
#pragma unroll
            for (int s = 0; s < 2; ++s) {
                pw[s] = (u32x4){cvt_pk_bf16(p0[8 * s], p0[8 * s + 1]), cvt_pk_bf16(p0[8 * s + 2], p0[8 * s + 3]), cvt_pk_bf16(p0[8 * s + 4], p0[8 * s + 5]), cvt_pk_bf16(p0[8 * s + 6], p0[8 * s + 7])};
                pw[2 + s] = (u32x4){cvt_pk_bf16(p1[8 * s], p1[8 * s + 1]), cvt_pk_bf16(p1[8 * s + 2], p1[8 * s + 3]), cvt_pk_bf16(p1[8 * s + 4], p1[8 * s + 5]), cvt_pk_bf16(p1[8 * s + 6], p1[8 * s + 7])};
            }
            if (lag) { pend = true; pend_vs = vslot; } else do_pv(vslot);
        }
        if (t < t1) A_STORE(cur ^ 1, vnext);
        __syncthreads();
        vslot = vnext;
    }
    if (pend) do_pv(pend_vs);
    __syncthreads();
    const float lt = l_run + __shfl_xor(l_run, 32);
    const float inv = 1.f / lt;
    bf16_t* dst = (MODE == 0 ? p.OA : p.OB) + qrow * 512 + h * 64 + 4 * hi;
#pragma unroll
    for (int g = 0; g < 4; ++g) {
        u32x2 w0, w1;
        w0.x = cvt_pk_bf16(o0[4 * g] * inv, o0[4 * g + 1] * inv); w0.y = cvt_pk_bf16(o0[4 * g + 2] * inv, o0[4 * g + 3] * inv);
        w1.x = cvt_pk_bf16(o1[4 * g] * inv, o1[4 * g + 1] * inv); w1.y = cvt_pk_bf16(o1[4 * g + 2] * inv, o1[4 * g + 3] * inv);
        *(u32x2*)(dst + 8 * g) = w0; *(u32x2*)(dst + 32 + 8 * g) = w1;
    }
#undef A_LOAD
#undef A_STORE
}


constexpr int C_K = 0, C_V = 5 * 8192, C_BIAS = 10 * 8192;
DI void ca_item(LAS unsigned char* lds, const Params& p, int b, int h, int qb) {
    int tid_ = threadIdx.x; asm volatile("" : "+v"(tid_));
    const int tid = tid_, lane = tid & 63, wid = __builtin_amdgcn_readfirstlane(tid >> 6), r32 = lane & 31, hi = lane >> 5;
    const size_t rowbase = (size_t)b * S;
    const size_t qrow = rowbase + qb * 256 + wid * 32 + r32;
    const int c = wid >> 1, first = qb * 4 - 8;
    bf16x8 qf[4];
    { const bf16_t* src = p.ZR + qrow * 2048 + 512 + h * 64;
#pragma unroll
      for (int ks = 0; ks < 4; ++ks) qf[ks] = *(const bf16x8*)(src + ks * 16 + hi * 8); }
    { float* bl = (float*)(lds + C_BIAS);
      for (int i = tid; i < 640; i += 512) bl[i] = p.rel_bias[(i > 512 ? 512 : i) * 8 + h] * LOG2E; }
    const float cbias = p.rel_bias[512 * 8 + h] * LOG2E;
    const int lkey = tid >> 3, lch = tid & 7;
    const bf16_t* ksrc = p.ZR + rowbase * 2048 + (size_t)lkey * 2048 + 1024 + h * 64 + lch * 8;
    const bf16_t* vsrc = ksrc + 512;
    const int kdst = C_K + lch * 1024 + lkey * 16, vdst = C_V + (lch >> 2) * 4096 + lkey * 64 + (lch & 3) * 16;
    const int kfo = C_K + hi * 1024 + r32 * 16;
    const int vfo = C_V + ((lane >> 4) & 1) * 32 + (lane & 3) * 8 + (4 * hi + ((lane & 15) >> 2)) * 64;
    const int qi = 32 * (wid & 1) + r32;
    float m_run = -1e30f, l_run = 0.f;
    f32x16 o0, o1;
#pragma unroll
    for (int r = 0; r < 16; ++r) { o0[r] = 0.f; o1[r] = 0.f; }
    { u32x4 kr[4], vr[4];
#pragma unroll
      for (int i = 0; i < 4; ++i) if (first + i >= 0) { kr[i] = *(const u32x4*)(ksrc + (size_t)(first + i) * 64 * 2048); vr[i] = *(const u32x4*)(vsrc + (size_t)(first + i) * 64 * 2048); }
#pragma unroll
      for (int i = 0; i < 4; ++i) if (first + i >= 0) { *(LAS u32x4*)(lds + i * 8192 + kdst) = kr[i]; *(LAS u32x4*)(lds + i * 8192 + vdst) = vr[i]; } }
    __syncthreads();
    const bool lag = wid >= 4;
    u32x4 pw[4];
    bool pend = false; int pend_slot = 0;
    auto do_pv = [&](int slot) {
        const LAS unsigned char* vp = lds + slot * 8192 + vfo;
#pragma unroll
        for (int s4 = 0; s4 < 4; ++s4) {
            const s16x4 a0 = vtr(vp + s4 * 1024), a1 = vtr(vp + s4 * 1024 + 512), b0 = vtr(vp + 4096 + s4 * 1024), b1 = vtr(vp + 4096 + s4 * 1024 + 512);
            const bf16x8 vf0 = (bf16x8){a0[0], a0[1], a0[2], a0[3], a1[0], a1[1], a1[2], a1[3]};
            const bf16x8 vf1 = (bf16x8){b0[0], b0[1], b0[2], b0[3], b1[0], b1[1], b1[2], b1[3]};
            const bf16x8 pf = __builtin_bit_cast(bf16x8, pw[s4]);
            o0 = MFMA32(vf0, pf, o0); o1 = MFMA32(vf1, pf, o1);
        }
    };
    for (int s = 0; s < 9; ++s) {
        const int tl = first + s + 4;
        const bool do_load = (s < 8) && (tl >= 0);
        u32x4 kreg, vreg;
        if (do_load) { kreg = *(const u32x4*)(ksrc + (size_t)tl * 64 * 2048); vreg = *(const u32x4*)(vsrc + (size_t)tl * 64 * 2048); }
        if (pend) { do_pv(pend_slot); pend = false; }
        const int tw = first + s + c;
        if (tw >= 0) {
            int slot = s + c; slot = slot >= 10 ? slot - 10 : (slot >= 5 ? slot - 5 : slot);
            const LAS unsigned char* kp = lds + slot * 8192 + kfo;
            f32x16 p0, p1;
            float cb_t = 0.f;
            const int dt = 8 - s;
            if (dt < 5) {
                const LAS float* bp = (const LAS float*)(lds + C_BIAS) + (64 * dt + qi + 193 - 4 * hi);
#pragma unroll
                for (int r = 0; r < 16; ++r) { const int cc = (r & 3) + 8 * (r >> 2); p0[r] = bp[63 - cc]; p1[r] = bp[31 - cc]; }
            } else {
                cb_t = cbias;
#pragma unroll
                for (int r = 0; r < 16; ++r) { p0[r] = 0.f; p1[r] = 0.f; }
            }
#pragma unroll
            for (int ks = 0; ks < 4; ++ks) {
                const bf16x8 k0 = *(const LAS bf16x8*)(kp + ks * 2048), k1 = *(const LAS bf16x8*)(kp + ks * 2048 + 512);
                p0 = MFMA32(k0, qf[ks], p0); p1 = MFMA32(k1, qf[ks], p1);
            }
            float mxa = MX3(p0[0], p0[1], p1[0]), mxb = MX3(p0[2], p0[3], p1[1]); mxa = MX3(mxa, p1[2], p1[3]);
#pragma unroll
            for (int r = 4; r < 16; r += 4) { mxa = MX3(mxa, p0[r], p0[r + 1]); mxb = MX3(mxb, p0[r + 2], p0[r + 3]); mxa = MX3(mxa, p1[r], p1[r + 1]); mxb = MX3(mxb, p1[r + 2], p1[r + 3]); }
            float mx = fmaxf(mxa, mxb);
            { auto rr = __builtin_amdgcn_permlane32_swap(__float_as_uint(mx), __float_as_uint(mx), false, false); mx = fmaxf(__uint_as_float(rr[0]), __uint_as_float(rr[1])); }
            mx += cb_t;
            if (__any(mx - m_run > 8.f)) {
                const float m_new = fmaxf(m_run, mx);
                const float alpha = __builtin_amdgcn_exp2f(m_run - m_new);
                m_run = m_new; l_run *= alpha;
                o0 = o0 * alpha; o1 = o1 * alpha;
            }
            { const float negref = cb_t - m_run; p0 = p0 + negref; p1 = p1 + negref; }
#pragma unroll
            for (int r = 0; r < 16; ++r) { p0[r] = __builtin_amdgcn_exp2f(p0[r]); p1[r] = __builtin_amdgcn_exp2f(p1[r]); }
            { const f32x16 sv = p0 + p1; const f32x8 s8 = sv.lo + sv.hi; const f32x4 s4v = s8.lo + s8.hi; const f32x2 s2 = s4v.lo + s4v.hi; l_run += s2.x + s2.y; }
#pragma unroll
            for (int q = 0; q < 2; ++q) {
                pw[q] = (u32x4){cvt_pk_bf16(p0[8 * q], p0[8 * q + 1]), cvt_pk_bf16(p0[8 * q + 2], p0[8 * q + 3]), cvt_pk_bf16(p0[8 * q + 4], p0[8 * q + 5]), cvt_pk_bf16(p0[8 * q + 6], p0[8 * q + 7])};
                pw[2 + q] = (u32x4){cvt_pk_bf16(p1[8 * q], p1[8 * q + 1]), cvt_pk_bf16(p1[8 * q + 2], p1[8 * q + 3]), cvt_pk_bf16(p1[8 * q + 4], p1[8 * q + 5]), cvt_pk_bf16(p1[8 * q + 6], p1[8 * q + 7])};
            }
            if (lag) { pend = true; pend_slot = slot; } else do_pv(slot);
        }
        if (do_load) { int ls = s + 4; ls = ls >= 10 ? ls - 10 : (ls >= 5 ? ls - 5 : ls);
            *(LAS u32x4*)(lds + ls * 8192 + kdst) = kreg; *(LAS u32x4*)(lds + ls * 8192 + vdst) = vreg; }
        __syncthreads();
    }
    if (pend) do_pv(pend_slot);
    const float lt = l_run + __shfl_xor(l_run, 32);
    const float inv = 1.f / lt;
    bf16_t* dst = p.OB + qrow * 512 + h * 64 + 4 * hi;
#pragma unroll
    for (int g = 0; g < 4; ++g) {
        u32x2 w0, w1;
        w0.x = cvt_pk_bf16(o0[4 * g] * inv, o0[4 * g + 1] * inv); w0.y = cvt_pk_bf16(o0[4 * g + 2] * inv, o0[4 * g + 3] * inv);
        w1.x = cvt_pk_bf16(o1[4 * g] * inv, o1[4 * g + 1] * inv); w1.y = cvt_pk_bf16(o1[4 * g + 2] * inv, o1[4 * g + 3] * inv);
        *(u32x2*)(dst + 8 * g) = w0; *(u32x2*)(dst + 32 + 8 * g) = w1;
    }
    __syncthreads();
}

DI int srcbase(int mode, int G, int N) {
    const int s = G * 32;
    if (mode == 0) return s < N ? s : -1;
    if (mode == 1) { const int pn = s >> 8, bj = (s >> 7) & 1, w = s & 127; return bj * DFF + pn * 128 + w; }
    if (s < 1024) return 1952 + s;
    if (s < 2048) return 2976 + (s - 1024);
    if (s < 2304) return s - 2048;
    if (s < 2432) return 256 + (s - 2304);
    if (s < 2464) return 384 + (s - 2432);
    if (s < 2560) return -1;
    return 416 + (s - 2560);
}

template <bool FINAL>
DI void norm_phase(const float* xin, const float* gain, const float* sh, const float* sc, bf16_t* Hout, float* fout) {
    int tid_ = threadIdx.x; asm volatile("" : "+v"(tid_));
    const int lane = tid_ & 63, wave = tid_ >> 6;
    for (int row = blockIdx.x * 8 + wave; row < T; row += gridDim.x * 8) {
        const f32x4* xr = (const f32x4*)(xin + (size_t)row * D);
        f32x4 v[4]; float ss = 0.f;
#pragma unroll
        for (int i = 0; i < 4; ++i) { v[i] = xr[i * 64 + lane]; ss += (v[i][0] * v[i][0] + v[i][1] * v[i][1]) + (v[i][2] * v[i][2] + v[i][3] * v[i][3]); }
#pragma unroll
        for (int o = 32; o >= 1; o >>= 1) ss += __shfl_xor(ss, o);
        const float rstd = rsqrtf(ss * (1.f / 1024.f) + EPSV);
        const int b = row >> 12;
#pragma unroll
        for (int i = 0; i < 4; ++i) {
            const int col = i * 256 + lane * 4;
            const f32x4 g = *(const f32x4*)(gain + col);
            f32x4 y = v[i] * rstd * g;
            if constexpr (!FINAL) {
                const f32x4 s1 = *(const f32x4*)(sc + b * NADA + col), s0 = *(const f32x4*)(sh + b * NADA + col);
                y = y * (s1 + 1.f) + s0;
                u32x2 w; w.x = cvt_pk_bf16(y[0], y[1]); w.y = cvt_pk_bf16(y[2], y[3]);
                *(u32x2*)(Hout + (size_t)row * D + col) = w;
            } else {
                *(f32x4*)(fout + (size_t)row * D + col) = y;
            }
        }
    }
}


template <bool FINAL>
DI void norm_phase_b(const bf16_t* xin, const float* gain, const float* sh, const float* sc, bf16_t* Hout, float* fout) {
    int tid_ = threadIdx.x; asm volatile("" : "+v"(tid_));
    const int lane = tid_ & 63, wave = tid_ >> 6;
    for (int row = blockIdx.x * 8 + wave; row < T; row += gridDim.x * 8) {
        f32x4 v[2][2]; float ss = 0.f;
#pragma unroll
        for (int i = 0; i < 2; ++i) { const u32x4 rw = *(const u32x4*)(xin + (size_t)row * D + i * 512 + lane * 8);
            v[i][0] = (f32x4){bflo(rw.x), bfhi(rw.x), bflo(rw.y), bfhi(rw.y)}; v[i][1] = (f32x4){bflo(rw.z), bfhi(rw.z), bflo(rw.w), bfhi(rw.w)};
#pragma unroll
            for (int h = 0; h < 2; ++h) ss += (v[i][h][0] * v[i][h][0] + v[i][h][1] * v[i][h][1]) + (v[i][h][2] * v[i][h][2] + v[i][h][3] * v[i][h][3]); }
#pragma unroll
        for (int o = 32; o >= 1; o >>= 1) ss += __shfl_xor(ss, o);
        const float rstd = rsqrtf(ss * (1.f / 1024.f) + EPSV);
        const int b = row >> 12;
#pragma unroll
        for (int i = 0; i < 2; ++i) {
            const int col = i * 512 + lane * 8;
            f32x4 y[2];
#pragma unroll
            for (int h = 0; h < 2; ++h) { y[h] = v[i][h] * rstd * (*(const f32x4*)(gain + col + 4 * h));
                if constexpr (!FINAL) y[h] = y[h] * (*(const f32x4*)(sc + b * NADA + col + 4 * h) + 1.f) + *(const f32x4*)(sh + b * NADA + col + 4 * h); }
            if constexpr (!FINAL) {
                u32x4 w; w.x = cvt_pk_bf16(y[0][0], y[0][1]); w.y = cvt_pk_bf16(y[0][2], y[0][3]); w.z = cvt_pk_bf16(y[1][0], y[1][1]); w.w = cvt_pk_bf16(y[1][2], y[1][3]);
                *(u32x4*)(Hout + (size_t)row * D + col) = w;
            } else { *(f32x4*)(fout + (size_t)row * D + col) = y[0]; *(f32x4*)(fout + (size_t)row * D + col + 4) = y[1]; }
        }
    }
}

#define XB_TMO      128
#define XB_XCNT(j)  (256  + 64 * (j))
#define XB_XSUB(j)  (1280 + 64 * (j))
#define XB_XGEN(j)  (2304 + 64 * (j))
#define XB_TOP      3328
#define XB_TOPGEN   3392
#define XCD_BAR_WORDS 3456
#define XB_SPIN_CAP (1u << 20)
DI unsigned xb_ld(unsigned* p)              { return __hip_atomic_load(p, __ATOMIC_RELAXED, __HIP_MEMORY_SCOPE_AGENT); }
DI unsigned xb_add(unsigned* p, unsigned v) { return __hip_atomic_fetch_add(p, v, __ATOMIC_RELAXED, __HIP_MEMORY_SCOPE_AGENT); }
DI unsigned xb_xcc_id() { return (unsigned)__builtin_amdgcn_s_getreg((3 << 11) | 20) & 0xFu; }
#define XB_SPIN(cond, bar) do { unsigned _sp = 0; while (cond) { __builtin_amdgcn_s_sleep(1); \
    if ((++_sp & 255u) == 0u) { if (xb_ld(&(bar)[XB_TMO])) break; if (_sp > XB_SPIN_CAP) { atomicAdd(&(bar)[XB_TMO], 1u); break; } } } } while (0)
struct XcdBarrier { unsigned* bar; unsigned x; volatile LAS unsigned* st; };
DI XcdBarrier xcd_barrier_post(unsigned* bar, volatile LAS unsigned* st) {
    XcdBarrier b; b.bar = bar; b.x = xb_xcc_id(); b.st = st;
    if (threadIdx.x == 0) (void)xb_add(&bar[XB_XCNT(b.x)], 1u);
    return b;
}
DI void xcd_barrier_complete(unsigned* bar, unsigned x, unsigned& nloc, unsigned& nx) {
    const unsigned G = gridDim.x * gridDim.y * gridDim.z;
    unsigned sum, cnt, mine, sp = 0u;
    for (;;) {
        sum = 0u; cnt = 0u; mine = 0u;
#pragma unroll
        for (unsigned j = 0; j < 16; ++j) { const unsigned c = xb_ld(&bar[XB_XCNT(j)]); sum += c; cnt += (c > 0u) ? 1u : 0u; mine = (j == x) ? c : mine; }
        if (sum == G) break;
        __builtin_amdgcn_s_sleep(1);
        if ((++sp & 255u) == 0u) { if (xb_ld(&bar[XB_TMO])) break; if (sp > XB_SPIN_CAP) { atomicAdd(&bar[XB_TMO], 1u); break; } }
    }
    nloc = mine > 0u ? mine : 1u; nx = cnt > 0u ? cnt : 1u;
}
DI void xcd_barrier(const XcdBarrier& b) {
    asm volatile("s_waitcnt vmcnt(0)" ::: "memory");
    __syncthreads();
    if (threadIdx.x == 0) {
        unsigned* bar = b.bar;
        __builtin_amdgcn_s_waitcnt(0);
        unsigned nloc = b.st[0], nx = b.st[1];
        if (nloc == 0u) { xcd_barrier_complete(bar, b.x, nloc, nx); b.st[0] = nloc; b.st[1] = nx; }
        const unsigned old = xb_add(&bar[XB_XSUB(b.x)], 1u);
        const unsigned gen = old / nloc;
        if (old + 1u == (gen + 1u) * nloc) {
            __builtin_amdgcn_fence(__ATOMIC_RELEASE, "agent");
            asm volatile("s_waitcnt vmcnt(0)" ::: "memory");
            const unsigned og = xb_add(&bar[XB_TOP], 1u);
            const unsigned tg = og / nx;
            if (og + 1u == (tg + 1u) * nx) xb_add(&bar[XB_TOPGEN], 1u);
            else XB_SPIN(xb_ld(&bar[XB_TOPGEN]) == tg, bar);
            __builtin_amdgcn_fence(__ATOMIC_ACQUIRE, "agent");
            xb_add(&bar[XB_XGEN(b.x)], 1u);
            asm volatile("s_waitcnt vmcnt(0)" ::: "memory");
        } else {
            XB_SPIN(xb_ld(&bar[XB_XGEN(b.x)]) == gen, bar);
            __builtin_amdgcn_fence(__ATOMIC_ACQUIRE, "agent");
            asm volatile("s_waitcnt vmcnt(0)" ::: "memory");
        }
    }
    __syncthreads();
}

__global__ void __launch_bounds__(512) mega(Params p) {
    extern __shared__ __attribute__((aligned(16))) unsigned char smem[];
    LAS unsigned char* lds = (LAS unsigned char*)smem;
    cg::grid_group grid = cg::this_grid();
    const int G = gridDim.x, cb = blockIdx.x, tid = threadIdx.x;
    const EpiArgs ea0 = {nullptr, nullptr, 0.f, nullptr, nullptr, nullptr, nullptr, nullptr, nullptr, nullptr};

    if (tid == 0) { *(LAS u32x4*)(lds + 131072) = (u32x4){0u, 0u, 0u, 0u}; }
    if (p.n_trans < 0) grid.sync();
    const XcdBarrier xb = xcd_barrier_post(p.bar, (volatile LAS unsigned*)(lds + 131072));
    {
        const int n_items = 144 + p.n_trans + 1024 + 128;
        float* fl = (float*)smem;
        for (int it = cb; it < n_items; it += G) {
            if (it < 144) {
                float* cact = fl;
                float* red = fl + 8192;
                for (int i = tid; i < 8192; i += 512) { const float cv = p.c[i]; cact[i] = cv * __builtin_amdgcn_rcpf(1.f + __expf(-cv)); }
                __syncthreads();
                const int w = tid >> 6, l = tid & 63, col = it * 64 + l;
                float a[8];
#pragma unroll
                for (int b = 0; b < 8; ++b) a[b] = 0.f;
                for (int k = w * 128; k < w * 128 + 128; ++k) {
                    const float wv = p.w_ada[(size_t)k * NADA + col];
#pragma unroll
                    for (int b = 0; b < 8; ++b) a[b] += cact[b * 1024 + k] * wv;
                }
#pragma unroll
                for (int b = 0; b < 8; ++b) red[(w * 8 + b) * 64 + l] = a[b];
                __syncthreads();
                { const int b = tid >> 6; float s = p.b_ada[col];
#pragma unroll
                  for (int ww = 0; ww < 8; ++ww) s += red[(ww * 8 + b) * 64 + l];
                  p.ada[b * NADA + col] = s; }
                __syncthreads();
            } else if (it < 144 + p.n_trans) {
                const int gt = it - 144;
                const float* src = p.wd[0].src; bf16_t* dst = p.wd[0].dst; const float* gain = p.wd[0].gain; int K = p.wd[0].K, N = p.wd[0].N, nslots = p.wd[0].nslots, mode = p.wd[0].mode, start = 0;
#pragma unroll
                for (int i = 1; i < 10; ++i) if (gt >= p.wd[i].start) { src = p.wd[i].src; dst = p.wd[i].dst; gain = p.wd[i].gain; K = p.wd[i].K; N = p.wd[i].N; nslots = p.wd[i].nslots; mode = p.wd[i].mode; start = p.wd[i].start; }
                const int lt = gt - start, nsb = nslots >> 6, sb = lt % nsb, kb = lt / nsb;
                { const int j = tid & 31, g = (tid >> 5) & 1, k0 = tid >> 6;
                  const int base = srcbase(mode, sb * 2 + g, N);
                  const int s32 = (sb * 2 + g) * 32;
                  const float cs = mode == 1 ? (((s32 >> 7) & 1) ? 0.6931471805599453f : LOG2E) : (mode == 2 && s32 < 2048 ? LOG2E : 1.f);
                  float v[16];
#pragma unroll
                  for (int r = 0; r < 16; ++r) { const int k = kb * 128 + k0 + 8 * r; v[r] = base >= 0 ? src[(size_t)k * N + base + j] : 0.f; }
                  if (gain) {
#pragma unroll
                      for (int r = 0; r < 16; ++r) v[r] *= gain[kb * 128 + k0 + 8 * r];
                  }
#pragma unroll
                  for (int r = 0; r < 16; ++r) fl[(k0 + 8 * r) * 65 + g * 32 + j] = v[r] * cs; }
                __syncthreads();
                { const int sl = tid >> 3, kc = tid & 7, gg = sl >> 5, jj = perm32(sl & 31);
#pragma unroll
                  for (int hh = 0; hh < 2; ++hh) {
                      float v[8];
#pragma unroll
                      for (int i = 0; i < 8; ++i) v[i] = fl[(hh * 64 + kc * 8 + i) * 65 + gg * 32 + jj];
                      u32x4 w; w.x = cvt_pk_bf16(v[0], v[1]); w.y = cvt_pk_bf16(v[2], v[3]); w.z = cvt_pk_bf16(v[4], v[5]); w.w = cvt_pk_bf16(v[6], v[7]);
                      *(u32x4*)(dst + (size_t)(sb * 64 + sl) * K + kb * 128 + hh * 64 + kc * 8) = w; } }
                __syncthreads();
            } else if (it < 144 + p.n_trans + 1024) {
                const int idx = (it - 144 - p.n_trans) * 512 + tid, tok = idx >> 4, j = idx & 15;
                const float inv_freq = exp2f(-(float)j * 0.8304820237218406f);
                const float ang = (float)p.pos[tok] * inv_freq;
                p.rope[tok * 32 + j] = cosf(ang); p.rope[tok * 32 + 16 + j] = sinf(ang);
            } else {
                const int idx = (it - 144 - p.n_trans - 1024) * 512 + tid;
                if (idx < T) p.ssq[idx] = 0.f; else p.sskv[idx - T] = 0.f;
            }
        }
    }
    xcd_barrier(xb);
    norm_phase<false>(p.x, p.ffn1_norm, p.ada + 0 * D, p.ada + 1 * D, p.H, nullptr);
    xcd_barrier(xb);
    gemm_phase<E_SWIGLU>(lds, p, p.H, D, p.wt1i, D, 128, 22, cb, 128 * 22, G, ea0);
    xcd_barrier(xb);
    const int pair_q = ((cb >> 4) << 3) | (cb & 7), pair_h = (cb >> 3) & 1;
    { const EpiArgs ea = {p.x, p.ada + 2 * D, 0.5f, p.mix_norm, p.ada + 4 * D, p.ada + 3 * D, p.H, nullptr, p.exch, p.bar + XCD_BAR_WORDS};
      for (int q = pair_q; q < 128; q += G / 2) gemm_phase<E_RESID, 1>(lds, p, p.ACT, DFF, p.wt1o, DFF, 128, 4, q * 4 + 2 * pair_h, q * 4 + 2 * pair_h + 2, 1, ea); }
    xcd_barrier(xb);
    gemm_phase<E_Z>(lds, p, p.H, D, p.wtin, D, 128, 16, cb, 128 * 16, G, ea0);
    xcd_barrier(xb);
    for (int it = (cb + 192) & 255; it < 64; it += G) {
        for (int e = tid; e < 8192; e += 512) {
            const int idx = it * 8192 + e, tok = idx >> 4, j = idx & 15;
            const float x1 = bf2f(p.ZR[(size_t)tok * 2048 + 384 + j]), x2 = bf2f(p.ZR[(size_t)tok * 2048 + 400 + j]);
            const float cc = p.rope[tok * 32 + j], sn = p.rope[tok * 32 + 16 + j];
            p.KPE[tok * 32 + j] = (bf16_t)(cvt_pk_bf16(x1 * cc - x2 * sn, 0.f) & 0xffffu);
            p.KPE[tok * 32 + 16 + j] = (bf16_t)(cvt_pk_bf16(x1 * sn + x2 * cc, 0.f) & 0xffffu);
        }
    }
    gemm_phase<E_QUP>(lds, p, p.ZR, 2048, p.wtuq, 256, 128, 3, (cb + 128) & 255, 384, G, ea0);
    gemm_phase<E_KVUP>(lds, p, p.ZR + 256, 2048, p.wtukv, 128, 128, 4, cb, 512, G, ea0);
    xcd_barrier(xb);
    for (int it = cb; it < 512 + 1024; it += G) {
        if (it < 512) { const int bh = (it & 7) + 8 * ((it >> 3) >> 3), j = (it >> 3) & 7;
            attn_item<0>(lds, p, bh >> 3, bh & 7, 15 - j); attn_item<0>(lds, p, bh >> 3, bh & 7, j); }
        else { const int i2 = it - 512, bh = (i2 & 7) + 8 * ((i2 >> 3) >> 4), qb = (i2 >> 3) & 15; ca_item(lds, p, bh >> 3, bh & 7, qb); }
    }
    xcd_barrier(xb);
    gemm_phase<E_BRB>(lds, p, p.OA, 512, p.wtba, 512, 128, 4, cb, 128 * 4, G, ea0, p.OB, p.wtbb);
    xcd_barrier(xb);
    { const EpiArgs ea = {nullptr, p.ada + 5 * D, 1.0f, p.ffn2_norm, p.ada + 7 * D, p.ada + 6 * D, p.H3, nullptr, p.exch + 128 * 2 * 256, p.bar + XCD_BAR_WORDS + 256};
      for (int q = pair_q; q < 128; q += G / 2) gemm_phase<E_RESIDB, 1>(lds, p, p.M, D, p.wto, D, 128, 4, q * 4 + 2 * pair_h, q * 4 + 2 * pair_h + 2, 1, ea); }
    xcd_barrier(xb);
    gemm_phase<E_SWIGLU>(lds, p, p.H3, D, p.wt2i, D, 128, 22, cb, 128 * 22, G, ea0);
    xcd_barrier(xb);
    { const EpiArgs ea = {nullptr, p.ada + 8 * D, 0.5f, p.final_norm, nullptr, nullptr, nullptr, p.out, p.exch + 2 * 128 * 2 * 256, p.bar + XCD_BAR_WORDS + 512};
      for (int q = pair_q; q < 128; q += G / 2) gemm_phase<E_RESIDB, 2>(lds, p, p.ACT, DFF, p.wt2o, DFF, 128, 4, q * 4 + 2 * pair_h, q * 4 + 2 * pair_h + 2, 1, ea); }
}

extern "C" void kernel_launch(void* const* d_in, const int* in_sizes, int n_in, void* d_out, int out_size, void* d_ws, size_t ws_size, hipStream_t stream) {
    (void)in_sizes; (void)n_in; (void)out_size;
    Params p; memset(&p, 0, sizeof(p));
    p.x = (const float*)d_in[0]; p.c = (const float*)d_in[1]; p.pos = (const int*)d_in[2]; p.w_ada = (const float*)d_in[3]; p.b_ada = (const float*)d_in[4];
    p.ffn1_norm = (const float*)d_in[5]; p.mix_norm = (const float*)d_in[8]; p.ffn2_norm = (const float*)d_in[18]; p.final_norm = (const float*)d_in[21];
    p.rel_bias = (const float*)d_in[14]; p.out = (float*)d_out;
    unsigned char* w = (unsigned char*)d_ws; size_t off = 0;
    auto take = [&](size_t bytes) { unsigned char* r = w + off; off += (bytes + 255) & ~(size_t)255; return r; };
    p.wt1i = (bf16_t*)take((size_t)5632 * 1024 * 2); p.wt1o = (bf16_t*)take((size_t)1024 * 2816 * 2); p.wtin = (bf16_t*)take((size_t)4096 * 1024 * 2);
    p.wtuq = (bf16_t*)take((size_t)768 * 256 * 2); p.wtukv = (bf16_t*)take((size_t)1024 * 128 * 2); p.wtba = (bf16_t*)take((size_t)1024 * 512 * 2); p.wtbb = (bf16_t*)take((size_t)1024 * 512 * 2);
    p.wto = (bf16_t*)take((size_t)1024 * 1024 * 2); p.wt2i = (bf16_t*)take((size_t)5632 * 1024 * 2); p.wt2o = (bf16_t*)take((size_t)1024 * 2816 * 2);
    p.ada = (float*)take((size_t)8 * NADA * 4); p.rope = (float*)take((size_t)T * 32 * 4); p.ssq = (float*)take((size_t)T * 4); p.sskv = (float*)take((size_t)T * 4);
    p.KPE = (bf16_t*)take((size_t)T * 32 * 2);
    p.bar = (unsigned*)take((size_t)(XCD_BAR_WORDS + 768) * 4);
    p.exch = (float*)take((size_t)3 * 128 * 2 * 256 * 4);
    unsigned char* ra = take((size_t)T * DFF * 2);
    p.ACT = (bf16_t*)ra; p.GATES = (bf16_t*)ra; p.QM = (bf16_t*)(ra + (size_t)T * 2048 * 2);
    unsigned char* rb = take((size_t)T * 1024 * 2);
    p.H = (bf16_t*)rb; p.KVM = (bf16_t*)rb; p.M = (bf16_t*)rb;
    p.ZR = (bf16_t*)d_out; p.TMP = (float*)d_out; p.H3 = (bf16_t*)d_out;
    p.XB = (bf16_t*)take((size_t)T * 1024 * 2);
    p.OA = (bf16_t*)take((size_t)T * 512 * 2); p.OB = (bf16_t*)take((size_t)T * 512 * 2);
    if (off > ws_size) { fprintf(stderr, "workspace too small: need %zu have %zu\n", off, ws_size); return; }
    struct WS { int in; bf16_t* dst; int K, N, nslots, mode, gain; };
    const WS ws[10] = {{6, p.wt1i, 1024, 5632, 5632, 1, -1}, {7, p.wt1o, 2816, 1024, 1024, 0, -1}, {9, p.wtin, 1024, 4000, 4096, 2, -1}, {11, p.wtuq, 256, 768, 768, 0, 10},
                       {13, p.wtukv, 128, 1024, 1024, 0, 12}, {15, p.wtba, 512, 1024, 1024, 0, -1}, {16, p.wtbb, 512, 1024, 1024, 0, -1}, {17, p.wto, 1024, 1024, 1024, 0, -1},
                       {19, p.wt2i, 1024, 5632, 5632, 1, -1}, {20, p.wt2o, 2816, 1024, 1024, 0, -1}};
    int start = 0;
    for (int i = 0; i < 10; ++i) {
        p.wd[i].src = (const float*)d_in[ws[i].in]; p.wd[i].dst = ws[i].dst; p.wd[i].gain = ws[i].gain >= 0 ? (const float*)d_in[ws[i].gain] : nullptr;
        p.wd[i].K = ws[i].K; p.wd[i].N = ws[i].N; p.wd[i].nslots = ws[i].nslots; p.wd[i].mode = ws[i].mode; p.wd[i].start = start; p.wd[i].pad = 0;
        start += (ws[i].nslots / 64) * (ws[i].K / 128);
    }
    p.n_trans = start;
    static int grid_blocks = 0;
    if (!grid_blocks) {
        hipFuncSetAttribute((const void*)mega, hipFuncAttributeMaxDynamicSharedMemorySize, LDS_BYTES);
        int dev = 0, cus = 0, per_cu = 0;
        hipGetDevice(&dev);
        hipDeviceGetAttribute(&cus, hipDeviceAttributeMultiprocessorCount, dev);
        hipOccupancyMaxActiveBlocksPerMultiprocessor(&per_cu, mega, 512, LDS_BYTES);
        if (per_cu > 1) per_cu = 1;
        grid_blocks = cus * per_cu;
        if (grid_blocks > 16) grid_blocks &= ~15;
    }
    hipMemsetAsync(p.bar, 0, (size_t)(XCD_BAR_WORDS + 768) * 4, stream);
    void* args[] = {&p};
    hipError_t e = hipLaunchCooperativeKernel((const void*)mega, dim3(grid_blocks), dim3(512), args, LDS_BYTES, stream);
    if (e != hipSuccess) fprintf(stderr, "cooperative launch failed: %s (grid %d)\n", hipGetErrorString(e), grid_blocks);
}
```

```cpp
#include <hip/hip_runtime.h>
#include <hip/hip_cooperative_groups.h>
#include <cstdio>
#include <cstdint>
#include <cstring>
namespace cg = cooperative_groups;

typedef unsigned short bf16_t;
typedef short bf16x8 __attribute__((ext_vector_type(8)));
typedef short s16x4 __attribute__((ext_vector_type(4)));
typedef float f32x4 __attribute__((ext_vector_type(4)));
typedef float f32x16 __attribute__((ext_vector_type(16)));
typedef float f32x8 __attribute__((ext_vector_type(8)));
typedef float f32x2 __attribute__((ext_vector_type(2)));
#define MX3(a, b, c) __builtin_fmaxf(__builtin_fmaxf((a), (b)), (c))
typedef unsigned u32x4 __attribute__((ext_vector_type(4)));
typedef unsigned u32x2 __attribute__((ext_vector_type(2)));
#define LAS __attribute__((address_space(3)))
#define DI __device__ __forceinline__

constexpr int T = 32768, S = 4096, D = 1024, DFF = 2816, NADA = 9216;
constexpr int LDS_BYTES = 131072 + 16 + 9216;
constexpr float EPSV = 1e-6f;
constexpr float LOG2E = 1.4426950408889634f;
constexpr float QSCALE = 0.10206207261596575f * 1.4426950408889634f;
constexpr float CASCALE = 0.125f * 1.4426950408889634f;

struct WDesc { const float* src; bf16_t* dst; const float* gain; int K, N, nslots, mode, start, pad; };
struct Params {
    const float *x, *c; const int* pos; const float *w_ada, *b_ada, *ffn1_norm, *mix_norm, *ffn2_norm, *final_norm, *rel_bias;
    float* out;
    WDesc wd[10];
    bf16_t *wt1i, *wt1o, *wtin, *wtuq, *wtukv, *wtba, *wtbb, *wto, *wt2i, *wt2o;
    float *ada, *rope, *ssq, *sskv;
    bf16_t *H, *ACT, *GATES, *QM, *KVM, *ZR, *OA, *OB, *KPE, *M, *XB; float* TMP;
    unsigned* bar; float* exch; bf16_t* H3;
    int n_trans, pad0;
};

DI unsigned cvt_pk_bf16(float lo, float hi) { unsigned r; asm volatile("v_cvt_pk_bf16_f32 %0, %1, %2" : "=v"(r) : "v"(lo), "v"(hi)); return r; }
DI float bf2f(unsigned short v) { return __uint_as_float(((unsigned)v) << 16); }
DI float bflo(unsigned w) { return __uint_as_float(w << 16); }
DI float bfhi(unsigned w) { return __uint_as_float(w & 0xffff0000u); }
DI int perm32(int rho) { const int n = rho >> 4, i = rho & 15; return 8 * (i >> 2) + 4 * n + (i & 3); }

constexpr int HTB = 128 * 64 * 2;
DI int lds_byte(int r, int c) { const int st = (r >> 4) * 2 + (c >> 5), rr = r & 15, cc = c & 31, ob = rr * 64 + cc * 2; return st * 1024 + (ob ^ (((ob >> 9) & 1) << 5)); }
DI void stage_rc(int b, int& R, int& C) { const int st = b / 1024, sb = b % 1024, swz = sb ^ (((sb >> 9) & 1) << 5); R = (st >> 1) * 16 + swz / 64; C = (st & 1) * 32 + (swz % 64) / 2; }

DI void tile_map(int L, int nM, int nN, int& pm, int& pn) {
    const int nwg = nM * nN; int wgid = L;
    { const int q = nwg / 8, r = nwg % 8, xcd = wgid % 8, off = wgid / 8; wgid = (xcd < r ? xcd * (q + 1) : r * (q + 1) + (xcd - r) * q) + off; }
    constexpr int WGM = 4;
    const int nig = WGM * nN, gid = wgid / nig, fm = gid * WGM, gsz = (nM - fm) < WGM ? (nM - fm) : WGM;
    pm = fm + ((wgid % nig) % gsz); pn = (wgid % nig) / gsz;
}

enum { E_SWIGLU = 0, E_RESID = 1, E_Z = 2, E_QUP = 3, E_KVUP = 4, E_BRA = 5, E_BRB = 6, E_RESIDB = 7 };
struct EpiArgs { const float* resid; const float* gate; float gs; const float* ngain; const float* nsc; const float* nsh; bf16_t* nout_h; float* nout_f; float* exch; unsigned* flags; };

DI float swi_f(float g, float u) { return (g * u) * __builtin_amdgcn_rcpf(1.f + __builtin_amdgcn_exp2f(-g)); }
DI float sigm_f(float g) { return __builtin_amdgcn_rcpf(1.f + __builtin_amdgcn_exp2f(-g)); }

template <int EPI, int FUSE = 0, bool LINMAP = false>
DI void gemm_phase(LAS unsigned char* lds, const Params& p, const bf16_t* A, int lda, const bf16_t* Bt, int K, int nM, int nN, int L0, int Lend, int G, const EpiArgs ea,
                   const bf16_t* A2 = nullptr, const bf16_t* Bt2 = nullptr, int pskip = 1 << 30) {
    constexpr bool DUAL = (EPI == E_BRB);
    int tid_ = threadIdx.x; asm volatile("" : "+v"(tid_));
    const int tid = tid_, wid = __builtin_amdgcn_readfirstlane(tid >> 6), lane = tid & 63, wr = wid >> 2, wc = wid & 3, fr = lane & 15, fq = lane >> 4;
    const int nt = K / 64;
    if (L0 >= Lend) return;
    unsigned voffA[2], voffB[2];
#pragma unroll
    for (int i = 0; i < 2; ++i) { int R, C; stage_rc(tid * 16 + i * 8192, R, C); voffA[i] = (unsigned)(R * lda + C); voffB[i] = (unsigned)(R * K + C); }
    int L = L0, pm, pn;
    if constexpr (FUSE > 0 || LINMAP) { pm = L / nN; pn = L % nN; } else { tile_map(L, nM, nN, pm, pn); if (pn >= pskip) pn += 2; }
    const bf16_t* Ab = A + (size_t)pm * 256 * lda;
    const bf16_t* Bb = Bt + (size_t)pn * 256 * K;
    const unsigned ldsw = (unsigned)wid * 1024u;
    const int aoff = lds_byte(wr * 64 + fr, fq * 8), boff = lds_byte(wc * 32 + fr, fq * 8);
#define G_SA(b, h) (((b) * 2 + (h)) * HTB)
#define G_SB(b, h) ((4 + (b) * 2 + (h)) * HTB)
#define G_STAGE(b, kt) do { _Pragma("unroll") for (int h_ = 0; h_ < 2; ++h_) { _Pragma("unroll") for (int i_ = 0; i_ < 2; ++i_) { \
        __builtin_amdgcn_global_load_lds((const unsigned*)(Bb + (size_t)h_ * 128 * K + (kt) * 64 + voffB[i_]), (LAS unsigned*)(lds + G_SB(b, h_) + ldsw + i_ * 8192), 16, 0, 0); \
        __builtin_amdgcn_global_load_lds((const unsigned*)(Ab + (size_t)h_ * 128 * lda + (kt) * 64 + voffA[i_]), (LAS unsigned*)(lds + G_SA(b, h_) + ldsw + i_ * 8192), 16, 0, 0); } } } while (0)
#define G_LDA(dst, b, h) do { _Pragma("unroll") for (int m = 0; m < 4; ++m) _Pragma("unroll") for (int k = 0; k < 2; ++k) dst[m][k] = *(const LAS bf16x8*)(lds + G_SA(b, h) + aoff + m * 2048 + k * 1024); } while (0)
#define G_LDB(dst, b, h) do { _Pragma("unroll") for (int n = 0; n < 2; ++n) _Pragma("unroll") for (int k = 0; k < 2; ++k) dst[n][k] = *(const LAS bf16x8*)(lds + G_SB(b, h) + boff + n * 2048 + k * 1024); } while (0)
#define G_MMA(ai, bj, At, Bf) do { _Pragma("unroll") for (int m = 0; m < 4; ++m) _Pragma("unroll") for (int n = 0; n < 2; ++n) _Pragma("unroll") for (int k = 0; k < 2; ++k) \
        acc[ai][bj][m][n] = __builtin_amdgcn_mfma_f32_16x16x32_bf16(Bf[n][k], At[m][k], acc[ai][bj][m][n], 0, 0, 0); } while (0)
#define G_STG_A(b, h, kt) do { const bf16_t* ub_ = Ab + (size_t)(h) * 128 * lda + (kt) * 64; asm volatile("" : "+s"(ub_)); _Pragma("unroll") for (int i_ = 0; i_ < 2; ++i_) \
        __builtin_amdgcn_global_load_lds((const unsigned*)(ub_ + voffA[i_]), (LAS unsigned*)(lds + G_SA(b, h) + ldsw + i_ * 8192), 16, 0, 0); } while (0)
#define G_STG_B(b, h, kt) do { const bf16_t* ub_ = Bb + (size_t)(h) * 128 * K + (kt) * 64; asm volatile("" : "+s"(ub_)); _Pragma("unroll") for (int i_ = 0; i_ < 2; ++i_) \
        __builtin_amdgcn_global_load_lds((const unsigned*)(ub_ + voffB[i_]), (LAS unsigned*)(lds + G_SB(b, h) + ldsw + i_ * 8192), 16, 0, 0); } while (0)
#define G_MMAP(ai, bj, At, Bf) do { __builtin_amdgcn_s_setprio(1); G_MMA(ai, bj, At, Bf); __builtin_amdgcn_s_setprio(0); } while (0)
#define WAIT_V(n) asm volatile("s_waitcnt vmcnt(" #n ")" ::: "memory")
#define WAIT_L(n) asm volatile("s_waitcnt lgkmcnt(" #n ")" ::: "memory")
#define BAR __builtin_amdgcn_s_barrier()
#define SCHED __builtin_amdgcn_sched_barrier(0)
#define G_STGP(bufoff, gp, voff) do { const bf16_t* ub_ = (gp); asm volatile("" : "+s"(ub_)); _Pragma("unroll") for (int i_ = 0; i_ < 2; ++i_) \
        __builtin_amdgcn_global_load_lds((const unsigned*)(ub_ + (voff)[i_]), (LAS unsigned*)(lds + (bufoff) + ldsw + i_ * 8192), 16, 0, 0); } while (0)
    f32x4 acc[2][2][4][2];
#define G_ZERO() do { _Pragma("unroll") for (int a = 0; a < 2; ++a) _Pragma("unroll") for (int b = 0; b < 2; ++b) _Pragma("unroll") for (int m = 0; m < 4; ++m) _Pragma("unroll") for (int n = 0; n < 2; ++n) acc[a][b][m][n] = (f32x4){0.f, 0.f, 0.f, 0.f}; } while (0)
    G_ZERO();
    auto epilogue = [&](int pm, int pn) {
    const int bidx = (pm * 256) >> 12;
    f32x4 hz[2][2] = {};
    if constexpr (EPI == E_RESID || EPI == E_RESIDB) {
#pragma unroll
        for (int bj = 0; bj < 2; ++bj) { const int col = pn * 256 + bj * 128 + wc * 32 + 8 * fq; const float gsc = ea.gs;
            const f32x4 t0 = *(const f32x4*)(ea.gate + bidx * NADA + col), t1 = *(const f32x4*)(ea.gate + bidx * NADA + col + 4);
            hz[bj][0] = (f32x4){t0[0] * gsc, t0[1] * gsc, t0[2] * gsc, t0[3] * gsc}; hz[bj][1] = (f32x4){t1[0] * gsc, t1[1] * gsc, t1[2] * gsc, t1[3] * gsc}; }
    }
#pragma unroll
    for (int ai = 0; ai < 2; ++ai)
#pragma unroll
        for (int m = 0; m < 4; ++m) {
            const int row = pm * 256 + ai * 128 + wr * 64 + m * 16 + fr;
            if constexpr (EPI == E_SWIGLU) {
                const int actcol = pn * 128 + wc * 32 + 8 * fq;
                const f32x4 g0 = acc[ai][0][m][0], g1 = acc[ai][0][m][1], u0 = acc[ai][1][m][0], u1 = acc[ai][1][m][1];
                u32x4 w;
                w.x = cvt_pk_bf16(swi_f(g0[0], u0[0]), swi_f(g0[1], u0[1])); w.y = cvt_pk_bf16(swi_f(g0[2], u0[2]), swi_f(g0[3], u0[3]));
                w.z = cvt_pk_bf16(swi_f(g1[0], u1[0]), swi_f(g1[1], u1[1])); w.w = cvt_pk_bf16(swi_f(g1[2], u1[2]), swi_f(g1[3], u1[3]));
                *(u32x4*)(p.ACT + (size_t)row * DFF + actcol) = w;
            } else if constexpr (EPI == E_Z) {
                float ss = 0.f;
#pragma unroll
                for (int bj = 0; bj < 2; ++bj) {
                    const int col = pn * 256 + bj * 128 + wc * 32 + 8 * fq;
                    f32x4 v0 = acc[ai][bj][m][0], v1 = acc[ai][bj][m][1];
                    if (pn == 8 || (pn == 9 && bj == 0)) ss += (v0[0] * v0[0] + v0[1] * v0[1]) + (v0[2] * v0[2] + v0[3] * v0[3]) + (v1[0] * v1[0] + v1[1] * v1[1]) + (v1[2] * v1[2] + v1[3] * v1[3]);
                    bf16_t* dst;
                    if (pn < 8) {
#pragma unroll
                        for (int j = 0; j < 4; ++j) { v0[j] = sigm_f(v0[j]); v1[j] = sigm_f(v1[j]); }
                        dst = p.GATES + (size_t)row * 2048 + col;
                    } else {
                        if (pn == 10 || pn == 11) { v0 = v0 * CASCALE; v1 = v1 * CASCALE; }
                        dst = p.ZR + (size_t)row * 2048 + (col - 2048);
                    }
                    u32x4 w; w.x = cvt_pk_bf16(v0[0], v0[1]); w.y = cvt_pk_bf16(v0[2], v0[3]); w.z = cvt_pk_bf16(v1[0], v1[1]); w.w = cvt_pk_bf16(v1[2], v1[3]);
                    *(u32x4*)dst = w;
                }
                if (pn == 8 || pn == 9) {
                    ss += __shfl_xor(ss, 16); ss += __shfl_xor(ss, 32);
                    if (fq == 0) unsafeAtomicAdd((pn == 8 ? p.ssq : p.sskv) + row, ss);
                }
            } else {
                float rs = 1.f;
                if constexpr (EPI == E_QUP) rs = rsqrtf(p.ssq[row] * (1.f / 256.f) + EPSV) * QSCALE;
                if constexpr (EPI == E_KVUP) rs = rsqrtf(p.sskv[row] * (1.f / 128.f) + EPSV);
#pragma unroll
                for (int bj = 0; bj < 2; ++bj) {
                    const int col = pn * 256 + bj * 128 + wc * 32 + 8 * fq;
                    const f32x4 v0 = acc[ai][bj][m][0], v1 = acc[ai][bj][m][1];
                    if constexpr (EPI == E_RESID || EPI == E_RESIDB) {
                        f32x4 r0, r1;
                        if constexpr (EPI == E_RESID) { r0 = *(const f32x4*)(ea.resid + (size_t)row * D + col); r1 = *(const f32x4*)(ea.resid + (size_t)row * D + col + 4); }
                        else { const u32x4 rw = *(const u32x4*)(p.XB + (size_t)row * D + col);
                            r0 = (f32x4){bflo(rw.x), bfhi(rw.x), bflo(rw.y), bfhi(rw.y)}; r1 = (f32x4){bflo(rw.z), bfhi(rw.z), bflo(rw.w), bfhi(rw.w)}; }
                        const f32x4 o0 = r0 + hz[bj][0] * v0, o1 = r1 + hz[bj][1] * v1;
                        u32x4 w; w.x = cvt_pk_bf16(o0[0], o0[1]); w.y = cvt_pk_bf16(o0[2], o0[3]); w.z = cvt_pk_bf16(o1[0], o1[1]); w.w = cvt_pk_bf16(o1[2], o1[3]);
                        *(u32x4*)(p.XB + (size_t)row * D + col) = w;
                    } else if constexpr (EPI == E_QUP) {
                        u32x4 w; w.x = cvt_pk_bf16(v0[0] * rs, v0[1] * rs); w.y = cvt_pk_bf16(v0[2] * rs, v0[3] * rs); w.z = cvt_pk_bf16(v1[0] * rs, v1[1] * rs); w.w = cvt_pk_bf16(v1[2] * rs, v1[3] * rs);
                        *(u32x4*)(p.QM + (size_t)row * 768 + col) = w;
                    } else if constexpr (EPI == E_KVUP) {
                        u32x4 w; w.x = cvt_pk_bf16(v0[0] * rs, v0[1] * rs); w.y = cvt_pk_bf16(v0[2] * rs, v0[3] * rs); w.z = cvt_pk_bf16(v1[0] * rs, v1[1] * rs); w.w = cvt_pk_bf16(v1[2] * rs, v1[3] * rs);
                        *(u32x4*)(p.KVM + (size_t)row * 1024 + col) = w;
                    } else if constexpr (EPI == E_BRB) {
                        const u32x4 gw = *(const u32x4*)(p.GATES + (size_t)row * 2048 + 1024 + col);
                        u32x4 w;
#define G_CLB(x) fmaxf((x), 1e-20f)
                        w.x = cvt_pk_bf16(G_CLB(bflo(gw.x)) * v0[0], G_CLB(bfhi(gw.x)) * v0[1]); w.y = cvt_pk_bf16(G_CLB(bflo(gw.y)) * v0[2], G_CLB(bfhi(gw.y)) * v0[3]);
                        w.z = cvt_pk_bf16(G_CLB(bflo(gw.z)) * v1[0], G_CLB(bfhi(gw.z)) * v1[1]); w.w = cvt_pk_bf16(G_CLB(bflo(gw.w)) * v1[2], G_CLB(bfhi(gw.w)) * v1[3]);
#undef G_CLB
                        *(u32x4*)(p.M + (size_t)row * D + col) = w;
                    }
                }
            }
        }
    };
    auto epilogue_fused = [&](int pm, int pn) {
        const int u = pn & 1, half = pn >> 1;
        const int bidx = (pm * 256) >> 12;
        LAS float* rs8 = (LAS float*)(lds + 131088);
        LAS float* rstd_l = rs8 + 2048;
        f32x4 hz[2][2];
#pragma unroll
        for (int bj = 0; bj < 2; ++bj) { const int col = pn * 256 + bj * 128 + wc * 32 + 8 * fq; const float gsc = ea.gs;
            const f32x4 t0 = *(const f32x4*)(ea.gate + bidx * NADA + col), t1 = *(const f32x4*)(ea.gate + bidx * NADA + col + 4);
            hz[bj][0] = (f32x4){t0[0] * gsc, t0[1] * gsc, t0[2] * gsc, t0[3] * gsc}; hz[bj][1] = (f32x4){t1[0] * gsc, t1[1] * gsc, t1[2] * gsc, t1[3] * gsc}; }
#pragma unroll
        for (int ai = 0; ai < 2; ++ai)
#pragma unroll
            for (int m = 0; m < 4; ++m) {
                const int row_l = ai * 128 + wr * 64 + m * 16 + fr, row = pm * 256 + row_l;
                float ss = 0.f;
#pragma unroll
                for (int bj = 0; bj < 2; ++bj) {
                    const int col = pn * 256 + bj * 128 + wc * 32 + 8 * fq;
                    f32x4 r0, r1;
                    if constexpr (EPI == E_RESID) { r0 = *(const f32x4*)(ea.resid + (size_t)row * D + col); r1 = *(const f32x4*)(ea.resid + (size_t)row * D + col + 4); }
                    else { const u32x4 rw = *(const u32x4*)(p.XB + (size_t)row * D + col);
                        r0 = (f32x4){bflo(rw.x), bfhi(rw.x), bflo(rw.y), bfhi(rw.y)}; r1 = (f32x4){bflo(rw.z), bfhi(rw.z), bflo(rw.w), bfhi(rw.w)}; }
                    const f32x4 o0 = r0 + hz[bj][0] * acc[ai][bj][m][0], o1 = r1 + hz[bj][1] * acc[ai][bj][m][1];
                    if (FUSE == 1 || u == 0) { u32x4 w; w.x = cvt_pk_bf16(o0[0], o0[1]); w.y = cvt_pk_bf16(o0[2], o0[3]); w.z = cvt_pk_bf16(o1[0], o1[1]); w.w = cvt_pk_bf16(o1[2], o1[3]);
                        *(u32x4*)(p.XB + (size_t)row * D + col) = w; }
                    ss += (o0[0] * o0[0] + o0[1] * o0[1]) + (o0[2] * o0[2] + o0[3] * o0[3]) + (o1[0] * o1[0] + o1[1] * o1[1]) + (o1[2] * o1[2] + o1[3] * o1[3]);
                    acc[ai][bj][m][0] = o0; acc[ai][bj][m][1] = o1;
                }
                ss += __shfl_xor(ss, 16); ss += __shfl_xor(ss, 32);
                if (fq == 0) rs8[(u * 4 + wc) * 256 + row_l] = ss;
            }
        if (u == 0) return;
        WAIT_L(0); BAR;
        int tid = threadIdx.x; asm volatile("" : "+v"(tid));
        float own = 0.f;
        if (tid < 256) {
#pragma unroll
            for (int k = 0; k < 8; ++k) own += rs8[k * 256 + tid];
            __hip_atomic_store(ea.exch + (size_t)(pm * 2 + half) * 256 + tid, own, __ATOMIC_RELAXED, __HIP_MEMORY_SCOPE_AGENT);
        }
        WAIT_V(0); BAR;
        if (tid == 0) {
            __hip_atomic_store(ea.flags + pm * 2 + half, 1u, __ATOMIC_RELAXED, __HIP_MEMORY_SCOPE_AGENT);
            unsigned sp = 0u;
            while (__hip_atomic_load(ea.flags + pm * 2 + (half ^ 1), __ATOMIC_RELAXED, __HIP_MEMORY_SCOPE_AGENT) == 0u) { __builtin_amdgcn_s_sleep(2); if (++sp > (1u << 22)) break; }
        }
        asm volatile("s_waitcnt vmcnt(0) lgkmcnt(0)" ::: "memory"); BAR; asm volatile("" ::: "memory");
        if (tid < 256) {
            const float oth = __hip_atomic_load(ea.exch + (size_t)(pm * 2 + (half ^ 1)) * 256 + tid, __ATOMIC_RELAXED, __HIP_MEMORY_SCOPE_AGENT);
            rstd_l[tid] = rsqrtf((own + oth) * (1.f / 1024.f) + EPSV);
        }
        asm volatile("s_waitcnt vmcnt(0) lgkmcnt(0)" ::: "memory"); BAR; asm volatile("" ::: "memory");
#pragma unroll
        for (int v = 1; v >= 0; --v) {
            const int pnv = pn - 1 + v;
#pragma unroll
            for (int bj = 0; bj < 2; ++bj) {
                const int col = pnv * 256 + bj * 128 + wc * 32 + 8 * fq;
                f32x4 Gn[2], Sn[2];
#pragma unroll
                for (int q = 0; q < 2; ++q) { Gn[q] = *(const f32x4*)(ea.ngain + col + 4 * q); Sn[q] = (f32x4){0.f, 0.f, 0.f, 0.f};
                    if constexpr (FUSE == 1) { Gn[q] = Gn[q] * (*(const f32x4*)(ea.nsc + bidx * NADA + col + 4 * q) + 1.f); Sn[q] = *(const f32x4*)(ea.nsh + bidx * NADA + col + 4 * q); } }
#pragma unroll
                for (int ai = 0; ai < 2; ++ai)
#pragma unroll
                    for (int m = 0; m < 4; ++m) {
                        const int row_l = ai * 128 + wr * 64 + m * 16 + fr, row = pm * 256 + row_l;
                        const float rs = rstd_l[row_l];
                        f32x4 x0, x1;
                        if (v == 1) { x0 = acc[ai][bj][m][0]; x1 = acc[ai][bj][m][1]; }
                        else { const u32x4 rw = *(const u32x4*)(p.XB + (size_t)row * D + col);
                            x0 = (f32x4){bflo(rw.x), bfhi(rw.x), bflo(rw.y), bfhi(rw.y)}; x1 = (f32x4){bflo(rw.z), bfhi(rw.z), bflo(rw.w), bfhi(rw.w)}; }
                        const f32x4 y0 = x0 * rs * Gn[0] + Sn[0], y1 = x1 * rs * Gn[1] + Sn[1];
                        if constexpr (FUSE == 1) { u32x4 w; w.x = cvt_pk_bf16(y0[0], y0[1]); w.y = cvt_pk_bf16(y0[2], y0[3]); w.z = cvt_pk_bf16(y1[0], y1[1]); w.w = cvt_pk_bf16(y1[2], y1[3]);
                            *(u32x4*)(ea.nout_h + (size_t)row * D + col) = w; }
                        else { *(f32x4*)(ea.nout_f + (size_t)row * D + col) = y0; *(f32x4*)(ea.nout_f + (size_t)row * D + col + 4) = y1; }
                    }
            }
        }
    };
    auto rescale = [&](int pm, int pn) {
#pragma unroll
            for (int ai = 0; ai < 2; ++ai)
#pragma unroll
                for (int m = 0; m < 4; ++m) {
                    const int row = pm * 256 + ai * 128 + wr * 64 + m * 16 + fr;
#pragma unroll
                    for (int bj = 0; bj < 2; ++bj) {
                        const int col = pn * 256 + bj * 128 + wc * 32 + 8 * fq;
                        const u32x4 ga = *(const u32x4*)(p.GATES + (size_t)row * 2048 + col), gb = *(const u32x4*)(p.GATES + (size_t)row * 2048 + 1024 + col);
#define G_RATIO(x, y) ((x) * __builtin_amdgcn_rcpf(fmaxf((y), 1e-20f)))
                        acc[ai][bj][m][0][0] *= G_RATIO(bflo(ga.x), bflo(gb.x)); acc[ai][bj][m][0][1] *= G_RATIO(bfhi(ga.x), bfhi(gb.x));
                        acc[ai][bj][m][0][2] *= G_RATIO(bflo(ga.y), bflo(gb.y)); acc[ai][bj][m][0][3] *= G_RATIO(bfhi(ga.y), bfhi(gb.y));
                        acc[ai][bj][m][1][0] *= G_RATIO(bflo(ga.z), bflo(gb.z)); acc[ai][bj][m][1][1] *= G_RATIO(bfhi(ga.z), bfhi(gb.z));
                        acc[ai][bj][m][1][2] *= G_RATIO(bflo(ga.w), bflo(gb.w)); acc[ai][bj][m][1][3] *= G_RATIO(bfhi(ga.w), bfhi(gb.w));
                    }
                    asm volatile("" ::: "memory");
                }

    };
    const size_t hsA = (size_t)128 * lda, hsB = (size_t)128 * K;
    const bf16_t* cA = Ab; const bf16_t* cB = Bb;
    G_STGP(G_SB(0, 0), cB, voffB); G_STGP(G_SB(0, 1), cB + hsB, voffB); G_STGP(G_SA(0, 0), cA, voffA); G_STGP(G_SA(0, 1), cA + hsA, voffA);
    if (wr == 1) BAR;
    WAIT_V(2); BAR;
    G_STGP(G_SB(1, 0), cB + 64, voffB); G_STGP(G_SA(1, 0), cA + 64, voffA); G_STGP(G_SB(1, 1), cB + hsB + 64, voffB);
    WAIT_V(6); BAR;
    int seg = 0;
    bf16x8 At[4][2], B0[2][2], B1[2][2];
    for (;;) {
        const bool mid = DUAL && seg == 0;
        const bool has_next_unit = (L + G < Lend);
        const bool has_next = mid || has_next_unit;
        int pmn = pm, pnn = pn;
        const bf16_t* nA = cA; const bf16_t* nB = cB;
        if (mid) { nA = A2 + (size_t)pm * 256 * lda; nB = Bt2 + (size_t)pn * 256 * K; }
        else if (has_next_unit) { if constexpr (FUSE > 0 || LINMAP) { pmn = (L + G) / nN; pnn = (L + G) % nN; } else { tile_map(L + G, nM, nN, pmn, pnn); if (pnn >= pskip) pnn += 2; } nA = A + (size_t)pmn * 256 * lda; nB = Bt + (size_t)pnn * 256 * K; }
        for (int t = 0; t < nt; t += 2) {
            const bool last = (t == nt - 2);
            const bf16_t* a1 = cA + (size_t)(t + 1) * 64;
            const bf16_t* a2 = last ? nA : cA + (size_t)(t + 2) * 64; const bf16_t* b2 = last ? nB : cB + (size_t)(t + 2) * 64;
            const bf16_t* a3 = a2 + 64; const bf16_t* b3 = b2 + 64;
            G_LDB(B0, 0, 0); G_LDB(B1, 0, 1); SCHED; G_LDA(At, 0, 0); G_STGP(G_SA(1, 1), a1 + hsA, voffA);
            WAIT_V(8); WAIT_L(0); BAR; G_MMAP(0, 0, At, B0); G_MMAP(0, 1, At, B1); BAR; SCHED;
            G_LDA(At, 0, 1); G_STGP(G_SB(0, 0), b2, voffB); G_STGP(G_SB(0, 1), b2 + hsB, voffB); G_STGP(G_SA(0, 0), a2, voffA);
            WAIT_V(8); WAIT_L(0); BAR; G_MMAP(1, 0, At, B0); G_MMAP(1, 1, At, B1); BAR; SCHED;
            G_LDB(B0, 1, 0); G_LDB(B1, 1, 1); SCHED; G_LDA(At, 1, 0); G_STGP(G_SA(0, 1), a2 + hsA, voffA);
            WAIT_V(8); WAIT_L(0); BAR; G_MMAP(0, 0, At, B0); G_MMAP(0, 1, At, B1); BAR; SCHED;
            G_LDA(At, 1, 1); G_STGP(G_SB(1, 0), b3, voffB); G_STGP(G_SB(1, 1), b3 + hsB, voffB); G_STGP(G_SA(1, 0), a3, voffA);
            WAIT_V(8); WAIT_L(0); BAR; G_MMAP(1, 0, At, B0); G_MMAP(1, 1, At, B1); BAR; SCHED;
        }
        if (wr == 0) BAR;
        if (mid) rescale(pm, pn); else { if constexpr (FUSE > 0) epilogue_fused(pm, pn); else epilogue(pm, pn); }
        if (!has_next) break;
        if (!mid) { G_ZERO(); pm = pmn; pn = pnn; L += G; }
        cA = nA; cB = nB; if (DUAL) seg ^= 1;
        if (wr == 1) BAR;
    }
    WAIT_V(0);
    BAR;
}

#define MFMA32(a, b, c) __builtin_amdgcn_mfma_f32_32x32x16_bf16(a, b, c, 0, 0, 0)
DI int crow(int r, int hi) { return (r & 3) + 8 * (r >> 2) + 4 * hi; }
typedef short v4i16_t __attribute__((ext_vector_type(4)));
DI s16x4 vtr(const LAS unsigned char* pp) { return __builtin_bit_cast(s16x4, __builtin_amdgcn_ds_read_tr16_b64_v4i16((LAS v4i16_t*)pp)); }

constexpr int A_KB = 12288, A_VOFF = 2 * A_KB, A_VB = 8192, A_BIAS = A_VOFF + 3 * A_VB;

template <int MODE>
DI void attn_item(LAS unsigned char* lds, const Params& p, int b, int h, int qb) {
    constexpr int NKS = MODE == 0 ? 6 : 4;
    int tid_ = threadIdx.x; asm volatile("" : "+v"(tid_));
    const int tid = tid_, lane = tid & 63, wid = __builtin_amdgcn_readfirstlane(tid >> 6), r32 = lane & 31, hi = lane >> 5;
    const size_t rowbase = (size_t)b * S;
    const int q0 = qb * 256;
    const size_t qrow = rowbase + q0 + wid * 32 + r32;
    const int cw = qb * 4 + (wid >> 1);
    const int t0 = MODE == 0 ? 0 : (qb * 4 - 8 > 0 ? qb * 4 - 8 : 0), t1 = qb * 4 + 3;
    bf16x8 qf[NKS];
    if constexpr (MODE == 0) {
        const bf16_t* src = p.QM + qrow * 768 + h * 96;
#pragma unroll
        for (int ks = 0; ks < 6; ++ks) qf[ks] = *(const bf16x8*)(src + ks * 16 + hi * 8);
        const float* rp = p.rope + qrow * 32 + 8 * hi;
        const f32x4 c0 = *(const f32x4*)(rp), c1 = *(const f32x4*)(rp + 4), s0 = *(const f32x4*)(rp + 16), s1 = *(const f32x4*)(rp + 20);
        bf16x8 a = qf[4], bq = qf[5], oa, ob;
#pragma unroll
        for (int j = 0; j < 8; ++j) {
            const float x1 = bf2f((unsigned short)a[j]), x2 = bf2f((unsigned short)bq[j]);
            const float cc = j < 4 ? c0[j & 3] : c1[j & 3], sn = j < 4 ? s0[j & 3] : s1[j & 3];
            const float y1 = x1 * cc - x2 * sn, y2 = x1 * sn + x2 * cc;
            oa[j] = (short)(cvt_pk_bf16(y1, 0.f) & 0xffffu); ob[j] = (short)(cvt_pk_bf16(y2, 0.f) & 0xffffu);
        }
        qf[4] = oa; qf[5] = ob;
    } else {
        const bf16_t* src = p.ZR + qrow * 2048 + 512 + h * 64;
#pragma unroll
        for (int ks = 0; ks < 4; ++ks) qf[ks] = *(const bf16x8*)(src + ks * 16 + hi * 8);
        float* bl = (float*)(lds + A_BIAS);
        for (int i = tid; i < 640; i += 512) bl[i] = p.rel_bias[(i > 512 ? 512 : i) * 8 + h] * LOG2E;
    }
    const int lkey = tid >> 3, lch = tid & 7;
    const bf16_t *ksrc, *vsrc, *pesrc = nullptr; size_t kstride;
    if constexpr (MODE == 0) {
        ksrc = p.KVM + rowbase * 1024 + (size_t)lkey * 1024 + h * 128 + lch * 8; vsrc = ksrc + 64; kstride = 1024;
        pesrc = p.KPE + rowbase * 32 + (size_t)(tid >> 2) * 32 + (tid & 3) * 8;
    } else {
        ksrc = p.ZR + rowbase * 2048 + (size_t)lkey * 2048 + 1024 + h * 64 + lch * 8; vsrc = ksrc + 512; kstride = 2048;
    }
    const int kdst = lch * 1024 + lkey * 16, vdst = A_VOFF + (lch >> 2) * 4096 + lkey * 64 + (lch & 3) * 16;
    const int pedst = (8 + (tid & 3)) * 1024 + (tid >> 2) * 16;
    u32x4 kreg, vreg, pereg;
#define A_LOAD(t) do { kreg = *(const u32x4*)(ksrc + (size_t)(t) * 64 * kstride); vreg = *(const u32x4*)(vsrc + (size_t)(t) * 64 * kstride); \
        if (MODE == 0 && tid < 256) pereg = *(const u32x4*)(pesrc + (size_t)(t) * 64 * 32); } while (0)
#define A_STORE(buf, vs) do { *(LAS u32x4*)(lds + (buf) * A_KB + kdst) = kreg; *(LAS u32x4*)(lds + (vs) * A_VB + vdst) = vreg; \
        if (MODE == 0 && tid < 256) *(LAS u32x4*)(lds + (buf) * A_KB + pedst) = pereg; } while (0)
    float m_run = -1e30f, l_run = 0.f;
    f32x16 o0, o1;
#pragma unroll
    for (int r = 0; r < 16; ++r) { o0[r] = 0.f; o1[r] = 0.f; }
    const int kfo = hi * 1024 + r32 * 16;
    const int vfo = A_VOFF + ((lane >> 4) & 1) * 32 + (lane & 3) * 8 + (4 * hi + ((lane & 15) >> 2)) * 64;
    const float cbias = MODE == 1 ? p.rel_bias[512 * 8 + h] * LOG2E : 0.f;
    const int qi = 32 * (wid & 1) + r32;
    const bool lag = wid >= 4;
    u32x4 pw[4];
    bool pend = false; int pend_vs = 0;
    auto do_pv = [&](int vs) {
        const LAS unsigned char* vp = lds + vs * A_VB + vfo;
#pragma unroll
            for (int s = 0; s < 4; ++s) {
                const s16x4 a0 = vtr(vp + s * 1024), a1 = vtr(vp + s * 1024 + 512), b0 = vtr(vp + 4096 + s * 1024), b1 = vtr(vp + 4096 + s * 1024 + 512);
                const bf16x8 vf0 = (bf16x8){a0[0], a0[1], a0[2], a0[3], a1[0], a1[1], a1[2], a1[3]};
                const bf16x8 vf1 = (bf16x8){b0[0], b0[1], b0[2], b0[3], b1[0], b1[1], b1[2], b1[3]};
                const bf16x8 pf = __builtin_bit_cast(bf16x8, pw[s]);
                o0 = MFMA32(vf0, pf, o0); o1 = MFMA32(vf1, pf, o1);
            }
    };
    A_LOAD(t0); A_STORE(0, 0);
    __syncthreads();
    int vslot = 0;
    for (int t = t0; t <= t1; ++t) {
        const int cur = (t - t0) & 1;
        const int vnext = vslot == 2 ? 0 : vslot + 1;
        if (t < t1) A_LOAD(t + 1);
        if (pend) { do_pv(pend_vs); pend = false; }
        const bool vis = MODE == 0 ? (t <= cw) : (t <= cw && t >= cw - 8);
        if (vis) {
            const LAS unsigned char* kp = lds + cur * A_KB + kfo;
            f32x16 p0, p1;
            float cb_t = 0.f;
            bool biased = false;
            if constexpr (MODE == 1) {
                const int dt = cw - t;
                if (dt < 5) {
                    biased = true;
                    const LAS float* bp = (const LAS float*)(lds + A_BIAS) + (64 * dt + qi + 193 - 4 * hi);
#pragma unroll
                    for (int r = 0; r < 16; ++r) { const int c = (r & 3) + 8 * (r >> 2); p0[r] = bp[63 - c]; p1[r] = bp[31 - c]; }
                } else cb_t = cbias;
            }
            if (!biased) {
#pragma unroll
                for (int r = 0; r < 16; ++r) { p0[r] = 0.f; p1[r] = 0.f; }
            }
#pragma unroll
            for (int ks = 0; ks < NKS; ++ks) {
                const bf16x8 k0 = *(const LAS bf16x8*)(kp + ks * 2048), k1 = *(const LAS bf16x8*)(kp + ks * 2048 + 512);
                p0 = MFMA32(k0, qf[ks], p0); p1 = MFMA32(k1, qf[ks], p1);
            }
            float mxa = MX3(p0[0], p0[1], p1[0]), mxb = MX3(p0[2], p0[3], p1[1]); mxa = MX3(mxa, p1[2], p1[3]);
#pragma unroll
            for (int r = 4; r < 16; r += 4) { mxa = MX3(mxa, p0[r], p0[r + 1]); mxb = MX3(mxb, p0[r + 2], p0[r + 3]); mxa = MX3(mxa, p1[r], p1[r + 1]); mxb = MX3(mxb, p1[r + 2], p1[r + 3]); }
            float mx = fmaxf(mxa, mxb);
            { auto rr = __builtin_amdgcn_permlane32_swap(__float_as_uint(mx), __float_as_uint(mx), false, false); mx = fmaxf(__uint_as_float(rr[0]), __uint_as_float(rr[1])); }
            mx += cb_t;
            if (__any(mx - m_run > 8.f)) {
                const float m_new = fmaxf(m_run, mx);
                const float alpha = __builtin_amdgcn_exp2f(m_run - m_new);
                m_run = m_new; l_run *= alpha;
                o0 = o0 * alpha; o1 = o1 * alpha;
            }
            { const float negref = cb_t - m_run; p0 = p0 + negref; p1 = p1 + negref; }
#pragma unroll
            for (int r = 0; r < 16; ++r) { p0[r] = __builtin_amdgcn_exp2f(p0[r]); p1[r] = __builtin_amdgcn_exp2f(p1[r]); }
            { const f32x16 sv = p0 + p1; const f32x8 s8 = sv.lo + sv.hi; const f32x4 s4 = s8.lo + s8.hi; const f32x2 s2 = s4.lo + s4.hi; l_run += s2.x + s2.y; }
#pragma unroll
            for (int s = 0; s < 2; ++s) {
                pw[s] = (u32x4){cvt_pk_bf16(p0[8 * s], p0[8 * s + 1]), cvt_pk_bf16(p0[8 * s + 2], p0[8 * s + 3]), cvt_pk_bf16(p0[8 * s + 4], p0[8 * s + 5]), cvt_pk_bf16(p0[8 * s + 6], p0[8 * s + 7])};
                pw[2 + s] = (u32x4){cvt_pk_bf16(p1[8 * s], p1[8 * s + 1]), cvt_pk_bf16(p1[8 * s + 2], p1[8 * s + 3]), cvt_pk_bf16(p1[8 * s + 4], p1[8 * s + 5]), cvt_pk_bf16(p1[8 * s + 6], p1[8 * s + 7])};
            }
            if (lag) { pend = true; pend_vs = vslot; } else do_pv(vslot);
        }
        if (t < t1) A_STORE(cur ^ 1, vnext);
        __syncthreads();
        vslot = vnext;
    }
    if (pend) do_pv(pend_vs);
    __syncthreads();
    const float lt = l_run + __shfl_xor(l_run, 32);
    const float inv = 1.f / lt;
    bf16_t* dst = (MODE == 0 ? p.OA : p.OB) + qrow * 512 + h * 64 + 4 * hi;
#pragma unroll
    for (int g = 0; g < 4; ++g) {
        u32x2 w0, w1;
        w0.x = cvt_pk_bf16(o0[4 * g] * inv, o0[4 * g + 1] * inv); w0.y = cvt_pk_bf16(o0[4 * g + 2] * inv, o0[4 * g + 3] * inv);
        w1.x = cvt_pk_bf16(o1[4 * g] * inv, o1[4 * g + 1] * inv); w1.y = cvt_pk_bf16(o1[4 * g + 2] * inv, o1[4 * g + 3] * inv);
        *(u32x2*)(dst + 8 * g) = w0; *(u32x2*)(dst + 32 + 8 * g) = w1;
    }
#undef A_LOAD
#undef A_STORE
}


constexpr int C_K = 0, C_V = 5 * 8192, C_BIAS = 10 * 8192;
DI void ca_item(LAS unsigned char* lds, const Params& p, int b, int h, int qb) {
    int tid_ = threadIdx.x; asm volatile("" : "+v"(tid_));
    const int tid = tid_, lane = tid & 63, wid = __builtin_amdgcn_readfirstlane(tid >> 6), r32 = lane & 31, hi = lane >> 5;
    const size_t rowbase = (size_t)b * S;
    const size_t qrow = rowbase + qb * 256 + wid * 32 + r32;
    const int c = wid >> 1, first = qb * 4 - 8;
    bf16x8 qf[4];
    { const bf16_t* src = p.ZR + qrow * 2048 + 512 + h * 64;
#pragma unroll
      for (int ks = 0; ks < 4; ++ks) qf[ks] = *(const bf16x8*)(src + ks * 16 + hi * 8); }
    { float* bl = (float*)(lds + C_BIAS);
      for (int i = tid; i < 640; i += 512) bl[i] = p.rel_bias[(i > 512 ? 512 : i) * 8 + h] * LOG2E; }
    const float cbias = p.rel_bias[512 * 8 + h] * LOG2E;
    const int lkey = tid >> 3, lch = tid & 7;
    const bf16_t* ksrc = p.ZR + rowbase * 2048 + (size_t)lkey * 2048 + 1024 + h * 64 + lch * 8;
    const bf16_t* vsrc = ksrc + 512;
    const int kdst = C_K + lch * 1024 + lkey * 16, vdst = C_V + (lch >> 2) * 4096 + lkey * 64 + (lch & 3) * 16;
    const int kfo = C_K + hi * 1024 + r32 * 16;
    const int vfo = C_V + ((lane >> 4) & 1) * 32 + (lane & 3) * 8 + (4 * hi + ((lane & 15) >> 2)) * 64;
    const int qi = 32 * (wid & 1) + r32;
    float m_run = -1e30f, l_run = 0.f;
    f32x16 o0, o1;
#pragma unroll
    for (int r = 0; r < 16; ++r) { o0[r] = 0.f; o1[r] = 0.f; }
    { u32x4 kr[4], vr[4];
#pragma unroll
      for (int i = 0; i < 4; ++i) if (first + i >= 0) { kr[i] = *(const u32x4*)(ksrc + (size_t)(first + i) * 64 * 2048); vr[i] = *(const u32x4*)(vsrc + (size_t)(first + i) * 64 * 2048); }
#pragma unroll
      for (int i = 0; i < 4; ++i) if (first + i >= 0) { *(LAS u32x4*)(lds + i * 8192 + kdst) = kr[i]; *(LAS u32x4*)(lds + i * 8192 + vdst) = vr[i]; } }
    __syncthreads();
    const bool lag = wid >= 4;
    u32x4 pw[4];
    bool pend = false; int pend_slot = 0;
    auto do_pv = [&](int slot) {
        const LAS unsigned char* vp = lds + slot * 8192 + vfo;
#pragma unroll
        for (int s4 = 0; s4 < 4; ++s4) {
            const s16x4 a0 = vtr(vp + s4 * 1024), a1 = vtr(vp + s4 * 1024 + 512), b0 = vtr(vp + 4096 + s4 * 1024), b1 = vtr(vp + 4096 + s4 * 1024 + 512);
            const bf16x8 vf0 = (bf16x8){a0[0], a0[1], a0[2], a0[3], a1[0], a1[1], a1[2], a1[3]};
            const bf16x8 vf1 = (bf16x8){b0[0], b0[1], b0[2], b0[3], b1[0], b1[1], b1[2], b1[3]};
            const bf16x8 pf = __builtin_bit_cast(bf16x8, pw[s4]);
            o0 = MFMA32(vf0, pf, o0); o1 = MFMA32(vf1, pf, o1);
        }
    };
    for (int s = 0; s < 9; ++s) {
        const int tl = first + s + 4;
        const bool do_load = (s < 8) && (tl >= 0);
        u32x4 kreg, vreg;
        if (do_load) { kreg = *(const u32x4*)(ksrc + (size_t)tl * 64 * 2048); vreg = *(const u32x4*)(vsrc + (size_t)tl * 64 * 2048); }
        if (pend) { do_pv(pend_slot); pend = false; }
        const int tw = first + s + c;
        if (tw >= 0) {
            int slot = s + c; slot = slot >= 10 ? slot - 10 : (slot >= 5 ? slot - 5 : slot);
            const LAS unsigned char* kp = lds + slot * 8192 + kfo;
            f32x16 p0, p1;
            float cb_t = 0.f;
            const int dt = 8 - s;
            if (dt < 5) {
                const LAS float* bp = (const LAS float*)(lds + C_BIAS) + (64 * dt + qi + 193 - 4 * hi);
#pragma unroll
                for (int r = 0; r < 16; ++r) { const int cc = (r & 3) + 8 * (r >> 2); p0[r] = bp[63 - cc]; p1[r] = bp[31 - cc]; }
            } else {
                cb_t = cbias;
#pragma unroll
                for (int r = 0; r < 16; ++r) { p0[r] = 0.f; p1[r] = 0.f; }
            }
#pragma unroll
            for (int ks = 0; ks < 4; ++ks) {
                const bf16x8 k0 = *(const LAS bf16x8*)(kp + ks * 2048), k1 = *(const LAS bf16x8*)(kp + ks * 2048 + 512);
                p0 = MFMA32(k0, qf[ks], p0); p1 = MFMA32(k1, qf[ks], p1);
            }
            float mxa = MX3(p0[0], p0[1], p1[0]), mxb = MX3(p0[2], p0[3], p1[1]); mxa = MX3(mxa, p1[2], p1[3]);
#pragma unroll
            for (int r = 4; r < 16; r += 4) { mxa = MX3(mxa, p0[r], p0[r + 1]); mxb = MX3(mxb, p0[r + 2], p0[r + 3]); mxa = MX3(mxa, p1[r], p1[r + 1]); mxb = MX3(mxb, p1[r + 2], p1[r + 3]); }
            float mx = fmaxf(mxa, mxb);
            { auto rr = __builtin_amdgcn_permlane32_swap(__float_as_uint(mx), __float_as_uint(mx), false, false); mx = fmaxf(__uint_as_float(rr[0]), __uint_as_float(rr[1])); }
            mx += cb_t;
            if (__any(mx - m_run > 8.f)) {
                const float m_new = fmaxf(m_run, mx);
                const float alpha = __builtin_amdgcn_exp2f(m_run - m_new);
                m_run = m_new; l_run *= alpha;
                o0 = o0 * alpha; o1 = o1 * alpha;
            }
            { const float negref = cb_t - m_run; p0 = p0 + negref; p1 = p1 + negref; }
#pragma unroll
            for (int r = 0; r < 16; ++r) { p0[r] = __builtin_amdgcn_exp2f(p0[r]); p1[r] = __builtin_amdgcn_exp2f(p1[r]); }
            { const f32x16 sv = p0 + p1; const f32x8 s8 = sv.lo + sv.hi; const f32x4 s4v = s8.lo + s8.hi; const f32x2 s2 = s4v.lo + s4v.hi; l_run += s2.x + s2.y; }
#pragma unroll
            for (int q = 0; q < 2; ++q) {
                pw[q] = (u32x4){cvt_pk_bf16(p0[8 * q], p0[8 * q + 1]), cvt_pk_bf16(p0[8 * q + 2], p0[8 * q + 3]), cvt_pk_bf16(p0[8 * q + 4], p0[8 * q + 5]), cvt_pk_bf16(p0[8 * q + 6], p0[8 * q + 7])};
                pw[2 + q] = (u32x4){cvt_pk_bf16(p1[8 * q], p1[8 * q + 1]), cvt_pk_bf16(p1[8 * q + 2], p1[8 * q + 3]), cvt_pk_bf16(p1[8 * q + 4], p1[8 * q + 5]), cvt_pk_bf16(p1[8 * q + 6], p1[8 * q + 7])};
            }
            if (lag) { pend = true; pend_slot = slot; } else do_pv(slot);
        }
        if (do_load) { int ls = s + 4; ls = ls >= 10 ? ls - 10 : (ls >= 5 ? ls - 5 : ls);
            *(LAS u32x4*)(lds + ls * 8192 + kdst) = kreg; *(LAS u32x4*)(lds + ls * 8192 + vdst) = vreg; }
        __syncthreads();
    }
    if (pend) do_pv(pend_slot);
    const float lt = l_run + __shfl_xor(l_run, 32);
    const float inv = 1.f / lt;
    bf16_t* dst = p.OB + qrow * 512 + h * 64 + 4 * hi;
#pragma unroll
    for (int g = 0; g < 4; ++g) {
        u32x2 w0, w1;
        w0.x = cvt_pk_bf16(o0[4 * g] * inv, o0[4 * g + 1] * inv); w0.y = cvt_pk_bf16(o0[4 * g + 2] * inv, o0[4 * g + 3] * inv);
        w1.x = cvt_pk_bf16(o1[4 * g] * inv, o1[4 * g + 1] * inv); w1.y = cvt_pk_bf16(o1[4 * g + 2] * inv, o1[4 * g + 3] * inv);
        *(u32x2*)(dst + 8 * g) = w0; *(u32x2*)(dst + 32 + 8 * g) = w1;
    }
    __syncthreads();
}

DI int srcbase(int mode, int G, int N) {
    const int s = G * 32;
    if (mode == 0) return s < N ? s : -1;
    if (mode == 1) { const int pn = s >> 8, bj = (s >> 7) & 1, w = s & 127; return bj * DFF + pn * 128 + w; }
    if (s < 1024) return 1952 + s;
    if (s < 2048) return 2976 + (s - 1024);
    if (s < 2304) return s - 2048;
    if (s < 2432) return 256 + (s - 2304);
    if (s < 2464) return 384 + (s - 2432);
    if (s < 2560) return -1;
    return 416 + (s - 2560);
}

template <bool FINAL>
DI void norm_phase(const float* xin, const float* gain, const float* sh, const float* sc, bf16_t* Hout, float* fout) {
    int tid_ = threadIdx.x; asm volatile("" : "+v"(tid_));
    const int lane = tid_ & 63, wave = tid_ >> 6;
    for (int row = blockIdx.x * 8 + wave; row < T; row += gridDim.x * 8) {
        const f32x4* xr = (const f32x4*)(xin + (size_t)row * D);
        f32x4 v[4]; float ss = 0.f;
#pragma unroll
        for (int i = 0; i < 4; ++i) { v[i] = xr[i * 64 + lane]; ss += (v[i][0] * v[i][0] + v[i][1] * v[i][1]) + (v[i][2] * v[i][2] + v[i][3] * v[i][3]); }
#pragma unroll
        for (int o = 32; o >= 1; o >>= 1) ss += __shfl_xor(ss, o);
        const float rstd = rsqrtf(ss * (1.f / 1024.f) + EPSV);
        const int b = row >> 12;
#pragma unroll
        for (int i = 0; i < 4; ++i) {
            const int col = i * 256 + lane * 4;
            const f32x4 g = *(const f32x4*)(gain + col);
            f32x4 y = v[i] * rstd * g;
            if constexpr (!FINAL) {
                const f32x4 s1 = *(const f32x4*)(sc + b * NADA + col), s0 = *(const f32x4*)(sh + b * NADA + col);
                y = y * (s1 + 1.f) + s0;
                u32x2 w; w.x = cvt_pk_bf16(y[0], y[1]); w.y = cvt_pk_bf16(y[2], y[3]);
                *(u32x2*)(Hout + (size_t)row * D + col) = w;
            } else {
                *(f32x4*)(fout + (size_t)row * D + col) = y;
            }
        }
    }
}


template <bool FINAL>
DI void norm_phase_b(const bf16_t* xin, const float* gain, const float* sh, const float* sc, bf16_t* Hout, float* fout) {
    int tid_ = threadIdx.x; asm volatile("" : "+v"(tid_));
    const int lane = tid_ & 63, wave = tid_ >> 6;
    for (int row = blockIdx.x * 8 + wave; row < T; row += gridDim.x * 8) {
        f32x4 v[2][2]; float ss = 0.f;
#pragma unroll
        for (int i = 0; i < 2; ++i) { const u32x4 rw = *(const u32x4*)(xin + (size_t)row * D + i * 512 + lane * 8);
            v[i][0] = (f32x4){bflo(rw.x), bfhi(rw.x), bflo(rw.y), bfhi(rw.y)}; v[i][1] = (f32x4){bflo(rw.z), bfhi(rw.z), bflo(rw.w), bfhi(rw.w)};
#pragma unroll
            for (int h = 0; h < 2; ++h) ss += (v[i][h][0] * v[i][h][0] + v[i][h][1] * v[i][h][1]) + (v[i][h][2] * v[i][h][2] + v[i][h][3] * v[i][h][3]); }
#pragma unroll
        for (int o = 32; o >= 1; o >>= 1) ss += __shfl_xor(ss, o);
        const float rstd = rsqrtf(ss * (1.f / 1024.f) + EPSV);
        const int b = row >> 12;
#pragma unroll
        for (int i = 0; i < 2; ++i) {
            const int col = i * 512 + lane * 8;
            f32x4 y[2];
#pragma unroll
            for (int h = 0; h < 2; ++h) { y[h] = v[i][h] * rstd * (*(const f32x4*)(gain + col + 4 * h));
                if constexpr (!FINAL) y[h] = y[h] * (*(const f32x4*)(sc + b * NADA + col + 4 * h) + 1.f) + *(const f32x4*)(sh + b * NADA + col + 4 * h); }
            if constexpr (!FINAL) {
                u32x4 w; w.x = cvt_pk_bf16(y[0][0], y[0][1]); w.y = cvt_pk_bf16(y[0][2], y[0][3]); w.z = cvt_pk_bf16(y[1][0], y[1][1]); w.w = cvt_pk_bf16(y[1][2], y[1][3]);
                *(u32x4*)(Hout + (size_t)row * D + col) = w;
            } else { *(f32x4*)(fout + (size_t)row * D + col) = y[0]; *(f32x4*)(fout + (size_t)row * D + col + 4) = y[1]; }
        }
    }
}

#define XB_TMO      128
#define XB_XCNT(j)  (256  + 64 * (j))
#define XB_XSUB(j)  (1280 + 64 * (j))
#define XB_XGEN(j)  (2304 + 64 * (j))
#define XB_TOP      3328
#define XB_TOPGEN   3392
#define XCD_BAR_WORDS 3456
#define XB_SPIN_CAP (1u << 20)
DI unsigned xb_ld(unsigned* p)              { return __hip_atomic_load(p, __ATOMIC_RELAXED, __HIP_MEMORY_SCOPE_AGENT); }
DI unsigned xb_add(unsigned* p, unsigned v) { return __hip_atomic_fetch_add(p, v, __ATOMIC_RELAXED, __HIP_MEMORY_SCOPE_AGENT); }
DI unsigned xb_xcc_id() { return (unsigned)__builtin_amdgcn_s_getreg((3 << 11) | 20) & 0xFu; }
#define XB_SPIN(cond, bar) do { unsigned _sp = 0; while (cond) { __builtin_amdgcn_s_sleep(1); \
    if ((++_sp & 255u) == 0u) { if (xb_ld(&(bar)[XB_TMO])) break; if (_sp > XB_SPIN_CAP) { atomicAdd(&(bar)[XB_TMO], 1u); break; } } } } while (0)
struct XcdBarrier { unsigned* bar; unsigned x; volatile LAS unsigned* st; };
DI XcdBarrier xcd_barrier_post(unsigned* bar, volatile LAS unsigned* st) {
    XcdBarrier b; b.bar = bar; b.x = xb_xcc_id(); b.st = st;
    if (threadIdx.x == 0) (void)xb_add(&bar[XB_XCNT(b.x)], 1u);
    return b;
}
DI void xcd_barrier_complete(unsigned* bar, unsigned x, unsigned& nloc, unsigned& nx) {
    const unsigned G = gridDim.x * gridDim.y * gridDim.z;
    unsigned sum, cnt, mine, sp = 0u;
    for (;;) {
        sum = 0u; cnt = 0u; mine = 0u;
#pragma unroll
        for (unsigned j = 0; j < 16; ++j) { const unsigned c = xb_ld(&bar[XB_XCNT(j)]); sum += c; cnt += (c > 0u) ? 1u : 0u; mine = (j == x) ? c : mine; }
        if (sum == G) break;
        __builtin_amdgcn_s_sleep(1);
        if ((++sp & 255u) == 0u) { if (xb_ld(&bar[XB_TMO])) break; if (sp > XB_SPIN_CAP) { atomicAdd(&bar[XB_TMO], 1u); break; } }
    }
    nloc = mine > 0u ? mine : 1u; nx = cnt > 0u ? cnt : 1u;
}
DI void xcd_barrier(const XcdBarrier& b) {
    asm volatile("s_waitcnt vmcnt(0)" ::: "memory");
    __syncthreads();
    if (threadIdx.x == 0) {
        unsigned* bar = b.bar;
        __builtin_amdgcn_s_waitcnt(0);
        unsigned nloc = b.st[0], nx = b.st[1];
        if (nloc == 0u) { xcd_barrier_complete(bar, b.x, nloc, nx); b.st[0] = nloc; b.st[1] = nx; }
        const unsigned old = xb_add(&bar[XB_XSUB(b.x)], 1u);
        const unsigned gen = old / nloc;
        if (old + 1u == (gen + 1u) * nloc) {
            __builtin_amdgcn_fence(__ATOMIC_RELEASE, "agent");
            asm volatile("s_waitcnt vmcnt(0)" ::: "memory");
            const unsigned og = xb_add(&bar[XB_TOP], 1u);
            const unsigned tg = og / nx;
            if (og + 1u == (tg + 1u) * nx) xb_add(&bar[XB_TOPGEN], 1u);
            else XB_SPIN(xb_ld(&bar[XB_TOPGEN]) == tg, bar);
            __builtin_amdgcn_fence(__ATOMIC_ACQUIRE, "agent");
            xb_add(&bar[XB_XGEN(b.x)], 1u);
            asm volatile("s_waitcnt vmcnt(0)" ::: "memory");
        } else {
            XB_SPIN(xb_ld(&bar[XB_XGEN(b.x)]) == gen, bar);
            __builtin_amdgcn_fence(__ATOMIC_ACQUIRE, "agent");
            asm volatile("s_waitcnt vmcnt(0)" ::: "memory");
        }
    }
    __syncthreads();
}

__global__ void __launch_bounds__(512) mega(Params p) {
    extern __shared__ __attribute__((aligned(16))) unsigned char smem[];
    LAS unsigned char* lds = (LAS unsigned char*)smem;
    cg::grid_group grid = cg::this_grid();
    const int G = gridDim.x, cb = blockIdx.x, tid = threadIdx.x;
    const EpiArgs ea0 = {nullptr, nullptr, 0.f, nullptr, nullptr, nullptr, nullptr, nullptr, nullptr, nullptr};

    if (tid == 0) { *(LAS u32x4*)(lds + 131072) = (u32x4){0u, 0u, 0u, 0u}; }
    if (p.n_trans < 0) grid.sync();
    const XcdBarrier xb = xcd_barrier_post(p.bar, (volatile LAS unsigned*)(lds + 131072));
    {
        const int n_items = 144 + p.n_trans + 1024 + 128;
        float* fl = (float*)smem;
        for (int it = cb; it < n_items; it += G) {
            if (it < 144) {
                float* cact = fl;
                float* red = fl + 8192;
                for (int i = tid; i < 8192; i += 512) { const float cv = p.c[i]; cact[i] = cv * __builtin_amdgcn_rcpf(1.f + __expf(-cv)); }
                __syncthreads();
                const int w = tid >> 6, l = tid & 63, col = it * 64 + l;
                float a[8];
#pragma unroll
                for (int b = 0; b < 8; ++b) a[b] = 0.f;
                for (int k = w * 128; k < w * 128 + 128; ++k) {
                    const float wv = p.w_ada[(size_t)k * NADA + col];
#pragma unroll
                    for (int b = 0; b < 8; ++b) a[b] += cact[b * 1024 + k] * wv;
                }
#pragma unroll
                for (int b = 0; b < 8; ++b) red[(w * 8 + b) * 64 + l] = a[b];
                __syncthreads();
                { const int b = tid >> 6; float s = p.b_ada[col];
#pragma unroll
                  for (int ww = 0; ww < 8; ++ww) s += red[(ww * 8 + b) * 64 + l];
                  p.ada[b * NADA + col] = s; }
                __syncthreads();
            } else if (it < 144 + p.n_trans) {
                const int gt = it - 144;
                const float* src = p.wd[0].src; bf16_t* dst = p.wd[0].dst; const float* gain = p.wd[0].gain; int K = p.wd[0].K, N = p.wd[0].N, nslots = p.wd[0].nslots, mode = p.wd[0].mode, start = 0;
#pragma unroll
                for (int i = 1; i < 10; ++i) if (gt >= p.wd[i].start) { src = p.wd[i].src; dst = p.wd[i].dst; gain = p.wd[i].gain; K = p.wd[i].K; N = p.wd[i].N; nslots = p.wd[i].nslots; mode = p.wd[i].mode; start = p.wd[i].start; }
                const int lt = gt - start, nsb = nslots >> 6, sb = lt % nsb, kb = lt / nsb;
                { const int j = tid & 31, g = (tid >> 5) & 1, k0 = tid >> 6;
                  const int base = srcbase(mode, sb * 2 + g, N);
                  const int s32 = (sb * 2 + g) * 32;
                  const float cs = mode == 1 ? (((s32 >> 7) & 1) ? 0.6931471805599453f : LOG2E) : (mode == 2 && s32 < 2048 ? LOG2E : 1.f);
                  float v[16];
#pragma unroll
                  for (int r = 0; r < 16; ++r) { const int k = kb * 128 + k0 + 8 * r; v[r] = base >= 0 ? src[(size_t)k * N + base + j] : 0.f; }
                  if (gain) {
#pragma unroll
                      for (int r = 0; r < 16; ++r) v[r] *= gain[kb * 128 + k0 + 8 * r];
                  }
#pragma unroll
                  for (int r = 0; r < 16; ++r) fl[(k0 + 8 * r) * 65 + g * 32 + j] = v[r] * cs; }
                __syncthreads();
                { const int sl = tid >> 3, kc = tid & 7, gg = sl >> 5, jj = perm32(sl & 31);
#pragma unroll
                  for (int hh = 0; hh < 2; ++hh) {
                      float v[8];
#pragma unroll
                      for (int i = 0; i < 8; ++i) v[i] = fl[(hh * 64 + kc * 8 + i) * 65 + gg * 32 + jj];
                      u32x4 w; w.x = cvt_pk_bf16(v[0], v[1]); w.y = cvt_pk_bf16(v[2], v[3]); w.z = cvt_pk_bf16(v[4], v[5]); w.w = cvt_pk_bf16(v[6], v[7]);
                      *(u32x4*)(dst + (size_t)(sb * 64 + sl) * K + kb * 128 + hh * 64 + kc * 8) = w; } }
                __syncthreads();
            } else if (it < 144 + p.n_trans + 1024) {
                const int idx = (it - 144 - p.n_trans) * 512 + tid, tok = idx >> 4, j = idx & 15;
                const float inv_freq = exp2f(-(float)j * 0.8304820237218406f);
                const float ang = (float)p.pos[tok] * inv_freq;
                p.rope[tok * 32 + j] = cosf(ang); p.rope[tok * 32 + 16 + j] = sinf(ang);
            } else {
                const int idx = (it - 144 - p.n_trans - 1024) * 512 + tid;
                if (idx < T) p.ssq[idx] = 0.f; else p.sskv[idx - T] = 0.f;
            }
        }
    }
    xcd_barrier(xb);
    norm_phase<false>(p.x, p.ffn1_norm, p.ada + 0 * D, p.ada + 1 * D, p.H, nullptr);
    xcd_barrier(xb);
    gemm_phase<E_SWIGLU>(lds, p, p.H, D, p.wt1i, D, 128, 22, cb, 128 * 22, G, ea0);
    xcd_barrier(xb);
    const int pair_q = ((cb >> 4) << 3) | (cb & 7), pair_h = (cb >> 3) & 1;
    { const EpiArgs ea = {p.x, p.ada + 2 * D, 0.5f, p.mix_norm, p.ada + 4 * D, p.ada + 3 * D, p.H, nullptr, p.exch, p.bar + XCD_BAR_WORDS};
      for (int q = pair_q; q < 128; q += G / 2) gemm_phase<E_RESID, 1>(lds, p, p.ACT, DFF, p.wt1o, DFF, 128, 4, q * 4 + 2 * pair_h, q * 4 + 2 * pair_h + 2, 1, ea); }
    xcd_barrier(xb);
    gemm_phase<E_Z>(lds, p, p.H, D, p.wtin, D, 128, 14, cb, 128 * 14, G, ea0, nullptr, nullptr, 8);
    for (int q = cb; q < 256; q += G) {
        const int pmL = q >> 1;
        gemm_phase<E_Z, 0, true>(lds, p, p.H, D, p.wtin, D, 128, 16, pmL * 16 + 8 + (q & 1), pmL * 16 + 8 + (q & 1) + 1, 1, ea0);
        if ((q & 1) == 0) {
            gemm_phase<E_QUP, 0, true>(lds, p, p.ZR, 2048, p.wtuq, 256, 128, 3, pmL * 3, pmL * 3 + 3, 1, ea0);
        } else {
#pragma unroll
            for (int r = 0; r < 8; ++r) {
                const int idx = pmL * 4096 + r * 512 + tid, tok = idx >> 4, j = idx & 15;
                const float x1 = bf2f(p.ZR[(size_t)tok * 2048 + 384 + j]), x2 = bf2f(p.ZR[(size_t)tok * 2048 + 400 + j]);
                const float cc = p.rope[tok * 32 + j], sn = p.rope[tok * 32 + 16 + j];
                p.KPE[tok * 32 + j] = (bf16_t)(cvt_pk_bf16(x1 * cc - x2 * sn, 0.f) & 0xffffu);
                p.KPE[tok * 32 + 16 + j] = (bf16_t)(cvt_pk_bf16(x1 * sn + x2 * cc, 0.f) & 0xffffu);
            }
            gemm_phase<E_KVUP, 0, true>(lds, p, p.ZR + 256, 2048, p.wtukv, 128, 128, 4, pmL * 4, pmL * 4 + 4, 1, ea0);
        }
    }
    xcd_barrier(xb);
    for (int it = cb; it < 512 + 1024; it += G) {
        if (it < 512) { const int bh = (it & 7) + 8 * ((it >> 3) >> 3), j = (it >> 3) & 7;
            attn_item<0>(lds, p, bh >> 3, bh & 7, 15 - j); attn_item<0>(lds, p, bh >> 3, bh & 7, j); }
        else { const int i2 = it - 512, bh = (i2 & 7) + 8 * ((i2 >> 3) >> 4), qb = (i2 >> 3) & 15; ca_item(lds, p, bh >> 3, bh & 7, qb); }
    }
    xcd_barrier(xb);
    gemm_phase<E_BRB>(lds, p, p.OA, 512, p.wtba, 512, 128, 4, cb, 128 * 4, G, ea0, p.OB, p.wtbb);
    xcd_barrier(xb);
    { const EpiArgs ea = {nullptr, p.ada + 5 * D, 1.0f, p.ffn2_norm, p.ada + 7 * D, p.ada + 6 * D, p.H3, nullptr, p.exch + 128 * 2 * 256, p.bar + XCD_BAR_WORDS + 256};
      for (int q = pair_q; q < 128; q += G / 2) gemm_phase<E_RESIDB, 1>(lds, p, p.M, D, p.wto, D, 128, 4, q * 4 + 2 * pair_h, q * 4 + 2 * pair_h + 2, 1, ea); }
    xcd_barrier(xb);
    gemm_phase<E_SWIGLU>(lds, p, p.H3, D, p.wt2i, D, 128, 22, cb, 128 * 22, G, ea0);
    xcd_barrier(xb);
    { const EpiArgs ea = {nullptr, p.ada + 8 * D, 0.5f, p.final_norm, nullptr, nullptr, nullptr, p.out, p.exch + 2 * 128 * 2 * 256, p.bar + XCD_BAR_WORDS + 512};
      for (int q = pair_q; q < 128; q += G / 2) gemm_phase<E_RESIDB, 2>(lds, p, p.ACT, DFF, p.wt2o, DFF, 128, 4, q * 4 + 2 * pair_h, q * 4 + 2 * pair_h + 2, 1, ea); }
}

extern "C" void kernel_launch(void* const* d_in, const int* in_sizes, int n_in, void* d_out, int out_size, void* d_ws, size_t ws_size, hipStream_t stream) {
    (void)in_sizes; (void)n_in; (void)out_size;
    Params p; memset(&p, 0, sizeof(p));
    p.x = (const float*)d_in[0]; p.c = (const float*)d_in[1]; p.pos = (const int*)d_in[2]; p.w_ada = (const float*)d_in[3]; p.b_ada = (const float*)d_in[4];
    p.ffn1_norm = (const float*)d_in[5]; p.mix_norm = (const float*)d_in[8]; p.ffn2_norm = (const float*)d_in[18]; p.final_norm = (const float*)d_in[21];
    p.rel_bias = (const float*)d_in[14]; p.out = (float*)d_out;
    unsigned char* w = (unsigned char*)d_ws; size_t off = 0;
    auto take = [&](size_t bytes) { unsigned char* r = w + off; off += (bytes + 255) & ~(size_t)255; return r; };
    p.wt1i = (bf16_t*)take((size_t)5632 * 1024 * 2); p.wt1o = (bf16_t*)take((size_t)1024 * 2816 * 2); p.wtin = (bf16_t*)take((size_t)4096 * 1024 * 2);
    p.wtuq = (bf16_t*)take((size_t)768 * 256 * 2); p.wtukv = (bf16_t*)take((size_t)1024 * 128 * 2); p.wtba = (bf16_t*)take((size_t)1024 * 512 * 2); p.wtbb = (bf16_t*)take((size_t)1024 * 512 * 2);
    p.wto = (bf16_t*)take((size_t)1024 * 1024 * 2); p.wt2i = (bf16_t*)take((size_t)5632 * 1024 * 2); p.wt2o = (bf16_t*)take((size_t)1024 * 2816 * 2);
    p.ada = (float*)take((size_t)8 * NADA * 4); p.rope = (float*)take((size_t)T * 32 * 4); p.ssq = (float*)take((size_t)T * 4); p.sskv = (float*)take((size_t)T * 4);
    p.KPE = (bf16_t*)take((size_t)T * 32 * 2);
    p.bar = (unsigned*)take((size_t)(XCD_BAR_WORDS + 768) * 4);
    p.exch = (float*)take((size_t)3 * 128 * 2 * 256 * 4);
    unsigned char* ra = take((size_t)T * DFF * 2);
    p.ACT = (bf16_t*)ra; p.GATES = (bf16_t*)ra; p.QM = (bf16_t*)(ra + (size_t)T * 2048 * 2);
    unsigned char* rb = take((size_t)T * 1024 * 2);
    p.H = (bf16_t*)rb; p.KVM = (bf16_t*)rb; p.M = (bf16_t*)rb;
    p.ZR = (bf16_t*)d_out; p.TMP = (float*)d_out; p.H3 = (bf16_t*)d_out;
    p.XB = (bf16_t*)take((size_t)T * 1024 * 2);
    p.OA = (bf16_t*)take((size_t)T * 512 * 2); p.OB = (bf16_t*)take((size_t)T * 512 * 2);
    if (off > ws_size) { fprintf(stderr, "workspace too small: need %zu have %zu\n", off, ws_size); return; }
    struct WS { int in; bf16_t* dst; int K, N, nslots, mode, gain; };
    const WS ws[10] = {{6, p.wt1i, 1024, 5632, 5632, 1, -1}, {7, p.wt1o, 2816, 1024, 1024, 0, -1}, {9, p.wtin, 1024, 4000, 4096, 2, -1}, {11, p.wtuq, 256, 768, 768, 0, 10},
                       {13, p.wtukv, 128, 1024, 1024, 0, 12}, {15, p.wtba, 512, 1024, 1024, 0, -1}, {16, p.wtbb, 512, 1024, 1024, 0, -1}, {17, p.wto, 1024, 1024, 1024, 0, -1},
                       {19, p.wt2i, 1024, 5632, 5632, 1, -1}, {20, p.wt2o, 2816, 1024, 1024, 0, -1}};
    int start = 0;
    for (int i = 0; i < 10; ++i) {
        p.wd[i].src = (const float*)d_in[ws[i].in]; p.wd[i].dst = ws[i].dst; p.wd[i].gain = ws[i].gain >= 0 ? (const float*)d_in[ws[i].gain] : nullptr;
        p.wd[i].K = ws[i].K; p.wd[i].N = ws[i].N; p.wd[i].nslots = ws[i].nslots; p.wd[i].mode = ws[i].mode; p.wd[i].start = start; p.wd[i].pad = 0;
        start += (ws[i].nslots / 64) * (ws[i].K / 128);
    }
    p.n_trans = start;
    static int grid_blocks = 0;
    if (!grid_blocks) {
        hipFuncSetAttribute((const void*)mega, hipFuncAttributeMaxDynamicSharedMemorySize, LDS_BYTES);
        int dev = 0, cus = 0, per_cu = 0;
        hipGetDevice(&dev);
        hipDeviceGetAttribute(&cus, hipDeviceAttributeMultiprocessorCount, dev);
        hipOccupancyMaxActiveBlocksPerMultiprocessor(&per_cu, mega, 512, LDS_BYTES);
        if (per_cu > 1) per_cu = 1;
        grid_blocks = cus * per_cu;
        if (grid_blocks > 16) grid_blocks &= ~15;
    }
    hipMemsetAsync(p.bar, 0, (size_t)(XCD_BAR_WORDS + 768) * 4, stream);
    void* args[] = {&p};
    hipError_t e = hipLaunchCooperativeKernel((const void*)mega, dim3(grid_blocks), dim3(512), args, LDS_BYTES, stream);
    if (e != hipSuccess) fprintf(stderr, "cooperative launch failed: %s (grid %d)\n", hipGetErrorString(e), grid_blocks);
}
```
